# Optimizing an MI355X kernel written in HIP

```python
import math
import jax, jax.numpy as jnp
from jax import lax
import numpy as np

D_MODEL = 1024
BATCH = 2
SEQ = 16384
DEPTH = 2

GRID_W = 64
CTX_LEN = 256
N_MOD = 9
MACARON_WEIGHT = 0.5
NORM_EPS = 1e-6
FFN_HIDDEN = 2816
GLA_HEADS = 4
GLA_DK = 64
GLA_DV = 128
GLA_QK = GLA_HEADS * GLA_DK
GLA_V = GLA_HEADS * GLA_DV
GLA_GATE_RANK = 16
GLA_TAU = 16.0
GLA_CHUNK = 64
S5_WIDTH = 512
S5_GROUP = 16
S5_GROUPS = S5_WIDTH // S5_GROUP
S5_STATE = 64
S5_DT_MIN = 1e-3
S5_DT_MAX = 1e-1
ATT_HEADS = 8
ATT_KV_HEADS = 2
ATT_GROUP = ATT_HEADS // ATT_KV_HEADS
ATT_HEAD_DIM = 64
ATT_Q = ATT_HEADS * ATT_HEAD_DIM
ATT_KV = ATT_KV_HEADS * ATT_HEAD_DIM
ATT_BLOCK = 128
ROPE_PAIRS = ATT_HEAD_DIM // 4
ROPE_THETA = 10000.0
BRANCH_WIDTH = 512
N_BRANCH = 3
IN_NAMES = ('gla_q', 'gla_k', 'gla_v', 'gla_gf', 'gla_gb', 'gla_r', 's5_u', 'att_q', 'att_k', 'att_v')
IN_WIDTHS = (GLA_QK, GLA_QK, GLA_V, GLA_GATE_RANK, GLA_GATE_RANK, GLA_V, S5_WIDTH, ATT_Q, ATT_KV, ATT_KV)
D_IN = sum(IN_WIDTHS)
F32 = jnp.float32

kernel_name = 'hybrid_gla_s5_gqa_macaron_prefix_dit'


def rms_norm(x, w):
    xf = x.astype(F32)
    y = xf * lax.rsqrt(jnp.mean(xf * xf, axis=-1, keepdims=True) + NORM_EPS)
    return (y * w.astype(F32)).astype(x.dtype)


def modulate(h, shift, scale):
    return h * (1 + scale) + shift


def swiglu(h, w_g, w_u, w_d):
    return (jax.nn.silu(h @ w_g) * (h @ w_u)) @ w_d


def ffn_sublayer(h, shift, scale, gate, g_norm, w_g, w_u, w_d):
    n = modulate(rms_norm(h, g_norm), shift, scale)
    return h + MACARON_WEIGHT * gate * swiglu(n, w_g, w_u, w_d)


def split_in(z):
    offsets = np.cumsum(IN_WIDTHS)[:-1].tolist()
    return dict(zip(IN_NAMES, jnp.split(z, offsets, axis=-1)))


def axial_rope_tables(n_tokens):
    rows = n_tokens // GRID_W
    row = jnp.repeat(jnp.arange(rows, dtype=F32), GRID_W)
    col = jnp.tile(jnp.arange(GRID_W, dtype=F32), rows)
    inv = ROPE_THETA ** (-jnp.arange(ROPE_PAIRS, dtype=F32) / ROPE_PAIRS)
    ang = jnp.stack([row[:, None] * inv, col[:, None] * inv], axis=1)
    return jnp.cos(ang), jnp.sin(ang)


def apply_rope(t, cos, sin):
    B, L, H, hd = t.shape
    tf = t.reshape(B, L, H, 2, 2, ROPE_PAIRS).astype(F32)
    t1, t2 = tf[..., 0, :], tf[..., 1, :]
    cs, sn = cos[None, :, None], sin[None, :, None]
    out = jnp.stack([t1 * cs - t2 * sn, t2 * cs + t1 * sn], axis=-2)
    return out.reshape(B, L, H, hd).astype(t.dtype)


def gla_inputs(z, gate_w, gate_b):
    B, L, _ = z['gla_q'].shape
    heads = lambda t, d: t.reshape(B, L, GLA_HEADS, d).astype(F32)
    q = heads(z['gla_q'], GLA_DK) * GLA_DK ** -0.5
    k = heads(z['gla_k'], GLA_DK)
    v = heads(z['gla_v'], GLA_DV)

    def log_decay(zg, w, b):
        return heads(jax.nn.log_sigmoid((zg @ w + b).astype(F32)), GLA_DK) / GLA_TAU

    return q, k, v, log_decay(z['gla_gf'], gate_w[0], gate_b[0]), log_decay(z['gla_gb'], gate_w[1], gate_b[1])


def gla_chunked(q, k, v, log_a, s0):
    B, L, H, dk = q.shape
    n = L // GLA_CHUNK
    rs = lambda t: t.reshape(B, n, GLA_CHUNK, H, t.shape[-1])
    q, k, v, g = rs(q), rs(k), rs(v), rs(log_a)
    b = jnp.cumsum(g, axis=2)
    b_last = b[:, :, -1:]
    q_in = q * jnp.exp(b)
    k_in = k * jnp.exp(-b)
    k_out = k * jnp.exp(b_last - b)
    mask = jnp.tril(jnp.ones((GLA_CHUNK, GLA_CHUNK), F32))
    att = jnp.einsum('bnihd,bnjhd->bnhij', q_in, k_in) * mask
    o_intra = jnp.einsum('bnhij,bnjhe->bnihe', att, v)
    d_state = jnp.einsum('bnjhd,bnjhe->bnhde', k_out, v)
    decay = jnp.exp(b_last[:, :, 0])

    def step(S, inp):
        dec, ds = inp
        return dec[..., None] * S + ds, S

    s_fin, s_prev = lax.scan(step, s0, (jnp.moveaxis(decay, 1, 0), jnp.moveaxis(d_state, 1, 0)))
    o_inter = jnp.einsum('bnihd,bnhde->bnihe', q_in, jnp.moveaxis(s_prev, 0, 1))
    return (o_intra + o_inter).reshape(B, L, H, -1), s_fin


def gla_bidir(q, k, v, g_f, g_b, s0_f, s0_b):
    flip = lambda t: t[:, ::-1]
    o_f, s_f = gla_chunked(q, k, v, g_f, s0_f)
    o_b, s_b = gla_chunked(flip(q), flip(k), flip(v), flip(g_b), s0_b)
    return o_f + flip(o_b), s_f, s_b


def gla_readout(o, r, norm_w):
    B, L = o.shape[:2]
    y = rms_norm(o, norm_w).reshape(B, L, GLA_V).astype(r.dtype)
    return y * jax.nn.silu(r)


def s5_discretise(a_re, a_im, log_dt, b_re, b_im):
    dt = jnp.exp(log_dt.astype(F32))[:, None]
    ar, ai = a_re.astype(F32), a_im.astype(F32)
    mag = jnp.exp(dt * ar)
    abar_re, abar_im = mag * jnp.cos(dt * ai), mag * jnp.sin(dt * ai)
    den = ar * ar + ai * ai
    xr, xi = abar_re - 1.0, abar_im
    coef_re = (xr * ar + xi * ai) / den
    coef_im = (xi * ar - xr * ai) / den
    br, bi = b_re.astype(F32), b_im.astype(F32)
    bbar_re = coef_re[..., None] * br - coef_im[..., None] * bi
    bbar_im = coef_re[..., None] * bi + coef_im[..., None] * br
    return abar_re, abar_im, bbar_re, bbar_im


def complex_scan_combine(e1, e2):
    a1r, a1i, b1r, b1i = e1
    a2r, a2i, b2r, b2i = e2
    return (a2r * a1r - a2i * a1i, a2r * a1i + a2i * a1r,
            a2r * b1r - a2i * b1i + b2r, a2r * b1i + a2i * b1r + b2i)


def s5_direction(u, disc, h0):
    abar_re, abar_im, bbar_re, bbar_im = disc
    h0_re, h0_im = h0
    bu_re = jnp.einsum('blgc,gpc->blgp', u, bbar_re)
    bu_im = jnp.einsum('blgc,gpc->blgp', u, bbar_im)
    bu_re = bu_re.at[:, 0].add(abar_re * h0_re - abar_im * h0_im)
    bu_im = bu_im.at[:, 0].add(abar_re * h0_im + abar_im * h0_re)
    shape = bu_re.shape
    _, _, h_re, h_im = lax.associative_scan(
        complex_scan_combine,
        (jnp.broadcast_to(abar_re, shape), jnp.broadcast_to(abar_im, shape), bu_re, bu_im), axis=1)
    return h_re, h_im


def s5_states(u_flat, disc_f, disc_b, h0_f, h0_b):
    B, L, _ = u_flat.shape
    u = u_flat.reshape(B, L, S5_GROUPS, S5_GROUP).astype(F32)
    hf_re, hf_im = s5_direction(u, disc_f, h0_f)
    hb_re, hb_im = s5_direction(u[:, ::-1], disc_b, h0_b)
    return (hf_re + hb_re[:, ::-1], hf_im + hb_im[:, ::-1],
            (hf_re[:, -1], hf_im[:, -1]), (hb_re[:, -1], hb_im[:, -1]))


def s5_readout(h_re, h_im, u_flat, c_re, c_im, d, glu_w, glu_b):
    B, L, _ = u_flat.shape
    u = u_flat.reshape(B, L, S5_GROUPS, S5_GROUP).astype(F32)
    y = (jnp.einsum('blgp,gcp->blgc', h_re, c_re.astype(F32))
         - jnp.einsum('blgp,gcp->blgc', h_im, c_im.astype(F32))
         + d.reshape(S5_GROUPS, S5_GROUP).astype(F32) * u)
    y = jax.nn.gelu(y.reshape(B, L, S5_WIDTH)).astype(u_flat.dtype)
    return y * jax.nn.sigmoid(y @ glu_w + glu_b)


def attn_inputs(z, q_norm_w, k_norm_w):
    B, L, _ = z['att_q'].shape
    q = rms_norm(z['att_q'].reshape(B, L, ATT_HEADS, ATT_HEAD_DIM), q_norm_w)
    k = rms_norm(z['att_k'].reshape(B, L, ATT_KV_HEADS, ATT_HEAD_DIM), k_norm_w)
    v = z['att_v'].reshape(B, L, ATT_KV_HEADS, ATT_HEAD_DIM)
    return q, k, v


def attend(q, k, v):
    B, Lq = q.shape[:2]
    nb = Lq // ATT_BLOCK
    qb = jnp.moveaxis(q.reshape(B, nb, ATT_BLOCK, ATT_KV_HEADS, ATT_GROUP, ATT_HEAD_DIM), 1, 0)
    scale = ATT_HEAD_DIM ** -0.5

    def one_block(qblk):
        s = jnp.einsum('bqkgd,bskd->bkgqs', qblk, k, preferred_element_type=F32) * scale
        p = jax.nn.softmax(s, axis=-1).astype(v.dtype)
        return jnp.einsum('bkgqs,bskd->bqkgd', p, v)

    o = lax.map(one_block, qb)
    return jnp.moveaxis(o, 0, 1).reshape(B, Lq, ATT_Q)


def merge_branches(n, y_gla, y_s5, y_att, p):
    g = jax.nn.sigmoid((n @ p['w_branch_gate'] + p['b_branch_gate']).astype(F32)).astype(n.dtype)
    g_gla, g_s5, g_att = jnp.split(g, N_BRANCH, axis=-1)
    wp = p['w_branch_proj']
    m = g_gla * (y_gla @ wp[0]) + g_s5 * (y_s5 @ wp[1]) + g_att * (y_att @ wp[2])
    return m @ p['w_out']


def token_mixer(n_ctx, n_lat, p, rope_cos, rope_sin, need_ctx_out):
    B = n_lat.shape[0]
    zc = split_in(n_ctx @ p['w_in'])
    zl = split_in(n_lat @ p['w_in'])
    qc, kc, vc, gfc, gbc = gla_inputs(zc, p['gla_gate_w'], p['gla_gate_b'])
    ql, kl, vl, gfl, gbl = gla_inputs(zl, p['gla_gate_w'], p['gla_gate_b'])
    s0 = jnp.zeros((B, GLA_HEADS, GLA_DK, GLA_DV), F32)
    o_gc, sf_c, sb_c = gla_bidir(qc, kc, vc, gfc, gbc, s0, s0)
    o_gl, _, _ = gla_bidir(ql, kl, vl, gfl, gbl, sf_c, sb_c)
    disc_f = s5_discretise(p['s5_a_re'][0], p['s5_a_im'][0], p['s5_log_dt'][0], p['s5_b_re'], p['s5_b_im'])
    disc_b = s5_discretise(p['s5_a_re'][1], p['s5_a_im'][1], p['s5_log_dt'][1], p['s5_b_re'], p['s5_b_im'])
    h0 = (jnp.zeros((B, S5_GROUPS, S5_STATE), F32), jnp.zeros((B, S5_GROUPS, S5_STATE), F32))
    hc_re, hc_im, hf_c, hb_c = s5_states(zc['s5_u'], disc_f, disc_b, h0, h0)
    hl_re, hl_im, _, _ = s5_states(zl['s5_u'], disc_f, disc_b, hf_c, hb_c)
    aqc, akc, avc = attn_inputs(zc, p['attn_q_norm_w'], p['attn_k_norm_w'])
    aql, akl, avl = attn_inputs(zl, p['attn_q_norm_w'], p['attn_k_norm_w'])
    aql = apply_rope(aql, rope_cos, rope_sin)
    akl = apply_rope(akl, rope_cos, rope_sin)
    y_att_l = attend(aql, jnp.concatenate([akc, akl], axis=1), jnp.concatenate([avc, avl], axis=1))
    y_gla_l = gla_readout(o_gl, zl['gla_r'], p['gla_norm_w'])
    y_s5_l = s5_readout(hl_re, hl_im, zl['s5_u'], p['s5_c_re'], p['s5_c_im'], p['s5_d'], p['s5_glu_w'], p['s5_glu_b'])
    out_l = merge_branches(n_lat, y_gla_l, y_s5_l, y_att_l, p)
    if not need_ctx_out:
        return None, out_l
    y_att_c = attend(aqc, akc, avc)
    y_gla_c = gla_readout(o_gc, zc['gla_r'], p['gla_norm_w'])
    y_s5_c = s5_readout(hc_re, hc_im, zc['s5_u'], p['s5_c_re'], p['s5_c_im'], p['s5_d'], p['s5_glu_w'], p['s5_glu_b'])
    out_c = merge_branches(n_ctx, y_gla_c, y_s5_c, y_att_c, p)
    return out_c, out_l


def setup_inputs(seed: int = 0) -> dict:
    key = jax.random.key(seed)
    ks = iter(jax.random.split(key, 40))
    D = D_MODEL

    def nrm(shape, scale):
        return jax.random.normal(next(ks), shape, F32) * scale

    a_im_base = jnp.pi * jnp.arange(S5_STATE, dtype=F32)
    return {
        'x': nrm((BATCH, SEQ, D), 1.0),
        'c': nrm((BATCH, D), 1.0),
        'ctx': nrm((BATCH, CTX_LEN, D), 1.0),
        'c_ctx': nrm((D,), 1.0),
        'w_ada': nrm((DEPTH, D, N_MOD * D), 0.5 * D ** -0.5),
        'b_ada': nrm((DEPTH, N_MOD * D), 0.02),
        'norm_w': 1.0 + nrm((DEPTH, 3, D), 0.02),
        'w_ffn_gate': nrm((DEPTH, 2, D, FFN_HIDDEN), D ** -0.5),
        'w_ffn_up': nrm((DEPTH, 2, D, FFN_HIDDEN), D ** -0.5),
        'w_ffn_down': nrm((DEPTH, 2, FFN_HIDDEN, D), FFN_HIDDEN ** -0.5),
        'w_in': nrm((DEPTH, D, D_IN), D ** -0.5),
        'gla_gate_w': nrm((DEPTH, 2, GLA_GATE_RANK, GLA_QK), GLA_GATE_RANK ** -0.5),
        'gla_gate_b': nrm((DEPTH, 2, GLA_QK), 0.1),
        'gla_norm_w': 1.0 + nrm((DEPTH, GLA_DV), 0.02),
        's5_a_re': -0.5 + nrm((DEPTH, 2, S5_GROUPS, S5_STATE), 0.01),
        's5_a_im': a_im_base + nrm((DEPTH, 2, S5_GROUPS, S5_STATE), 0.01),
        's5_log_dt': jax.random.uniform(next(ks), (DEPTH, 2, S5_GROUPS), F32,
                                        minval=math.log(S5_DT_MIN), maxval=math.log(S5_DT_MAX)),
        's5_b_re': nrm((DEPTH, S5_GROUPS, S5_STATE, S5_GROUP), (2 * S5_GROUP) ** -0.5),
        's5_b_im': nrm((DEPTH, S5_GROUPS, S5_STATE, S5_GROUP), (2 * S5_GROUP) ** -0.5),
        's5_c_re': nrm((DEPTH, S5_GROUPS, S5_GROUP, S5_STATE), S5_STATE ** -0.5),
        's5_c_im': nrm((DEPTH, S5_GROUPS, S5_GROUP, S5_STATE), S5_STATE ** -0.5),
        's5_d': nrm((DEPTH, S5_WIDTH), 1.0),
        's5_glu_w': nrm((DEPTH, S5_WIDTH, S5_WIDTH), S5_WIDTH ** -0.5),
        's5_glu_b': nrm((DEPTH, S5_WIDTH), 0.02),
        'attn_q_norm_w': 1.0 + nrm((DEPTH, ATT_HEAD_DIM), 0.02),
        'attn_k_norm_w': 1.0 + nrm((DEPTH, ATT_HEAD_DIM), 0.02),
        'w_branch_gate': nrm((DEPTH, D, N_BRANCH * D), D ** -0.5),
        'b_branch_gate': nrm((DEPTH, N_BRANCH * D), 0.02),
        'w_branch_proj': nrm((DEPTH, N_BRANCH, BRANCH_WIDTH, D), BRANCH_WIDTH ** -0.5),
        'w_out': nrm((DEPTH, D, D), D ** -0.5),
        'final_norm_w': 1.0 + nrm((D,), 0.02),
    }


def reference(x, c, ctx, c_ctx, w_ada, b_ada, norm_w, w_ffn_gate, w_ffn_up, w_ffn_down, w_in,
              gla_gate_w, gla_gate_b, gla_norm_w, s5_a_re, s5_a_im, s5_log_dt, s5_b_re, s5_b_im,
              s5_c_re, s5_c_im, s5_d, s5_glu_w, s5_glu_b, attn_q_norm_w, attn_k_norm_w,
              w_branch_gate, b_branch_gate, w_branch_proj, w_out, final_norm_w):
    rope_cos, rope_sin = axial_rope_tables(x.shape[1])
    sc = jax.nn.silu(c)
    scc = jax.nn.silu(c_ctx)
    h_lat, h_ctx = x, ctx
    for i in range(DEPTH):
        last = i == DEPTH - 1
        mod_l = jnp.split((sc @ w_ada[i] + b_ada[i])[:, None, :], N_MOD, axis=-1)
        mod_c = jnp.split((scc @ w_ada[i] + b_ada[i])[None, None, :], N_MOD, axis=-1)
        h_lat = ffn_sublayer(h_lat, mod_l[0], mod_l[1], mod_l[2], norm_w[i, 0],
                             w_ffn_gate[i, 0], w_ffn_up[i, 0], w_ffn_down[i, 0])
        h_ctx = ffn_sublayer(h_ctx, mod_c[0], mod_c[1], mod_c[2], norm_w[i, 0],
                             w_ffn_gate[i, 0], w_ffn_up[i, 0], w_ffn_down[i, 0])
        n_l = modulate(rms_norm(h_lat, norm_w[i, 1]), mod_l[3], mod_l[4])
        n_c = modulate(rms_norm(h_ctx, norm_w[i, 1]), mod_c[3], mod_c[4])
        p = {
            'w_in': w_in[i], 'gla_gate_w': gla_gate_w[i], 'gla_gate_b': gla_gate_b[i],
            'gla_norm_w': gla_norm_w[i], 's5_a_re': s5_a_re[i], 's5_a_im': s5_a_im[i],
            's5_log_dt': s5_log_dt[i], 's5_b_re': s5_b_re[i], 's5_b_im': s5_b_im[i],
            's5_c_re': s5_c_re[i], 's5_c_im': s5_c_im[i], 's5_d': s5_d[i],
            's5_glu_w': s5_glu_w[i], 's5_glu_b': s5_glu_b[i],
            'attn_q_norm_w': attn_q_norm_w[i], 'attn_k_norm_w': attn_k_norm_w[i],
            'w_branch_gate': w_branch_gate[i], 'b_branch_gate': b_branch_gate[i],
            'w_branch_proj': w_branch_proj[i], 'w_out': w_out[i],
        }
        out_c, out_l = token_mixer(n_c, n_l, p, rope_cos, rope_sin, not last)
        h_lat = h_lat + mod_l[5] * out_l
        h_lat = ffn_sublayer(h_lat, mod_l[6], mod_l[7], mod_l[8], norm_w[i, 2],
                             w_ffn_gate[i, 1], w_ffn_up[i, 1], w_ffn_down[i, 1])
        if not last:
            h_ctx = h_ctx + mod_c[5] * out_c
            h_ctx = ffn_sublayer(h_ctx, mod_c[6], mod_c[7], mod_c[8], norm_w[i, 2],
                                 w_ffn_gate[i, 1], w_ffn_up[i, 1], w_ffn_down[i, 1])
    return rms_norm(h_lat, final_norm_w)
```

```cpp
#include <hip/hip_runtime.h>
#include <hip/hip_cooperative_groups.h>
#include <hip/hip_bf16.h>
#include <cstdio>
#include <cstdint>
#include <cmath>
namespace cg = cooperative_groups;

#define LAS __attribute__((address_space(3)))
typedef unsigned short bf16_t;
typedef short bf16x8 __attribute__((ext_vector_type(8)));
typedef float f32x4 __attribute__((ext_vector_type(4)));
typedef float f32x2 __attribute__((ext_vector_type(2)));
typedef unsigned u32x4 __attribute__((ext_vector_type(4)));
typedef unsigned u32x2 __attribute__((ext_vector_type(2)));

constexpr int DM = 1024, MLAT = 32768, MCTX = 512, MT = 33280, SEQL = 16384, CTXL = 256, KVL = 16640;
constexpr int FFH = 2816, ZP = 2848, NCH = 260, NMOD = 9216;
constexpr float EPS = 1e-6f;
constexpr int ZQ = 0, ZK = 512, ZV = 640, GQ = 768, GK = 1024, GV = 1280, GR = 1792, SU = 2304, GFB = 2816;
constexpr size_t MiB = 1u << 20;
constexpr size_t WS_MODS = 0;
constexpr size_t WS_ROPE = 256 * 1024;
constexpr size_t WS_S5A = 320 * 1024;
constexpr size_t WS_S5B = 448 * 1024;
constexpr size_t WS_S5C = 960 * 1024;
constexpr size_t WS_GD = 2 * MiB;
constexpr size_t WS_HCTX = 4 * MiB;
constexpr size_t WS_W = 8 * MiB;
constexpr size_t W_GU = 0, W_DN = W_GU + 2ull * 5632 * 1024 * 2, W_IN = W_DN + 2ull * 1024 * 2816 * 2, W_BG = W_IN + 3072ull * 1024 * 2,
                 W_PJ = W_BG + 3072ull * 1024 * 2, W_O3 = W_PJ + 3072ull * 512 * 2, W_GL = W_O3 + 1024ull * 3072 * 2, W_END = W_GL + 512ull * 512 * 2;
static_assert(W_END <= 55 * MiB, "weights");
constexpr size_t WS_XN = 63 * MiB;
constexpr size_t WS_A = 128 * MiB;
constexpr size_t WS_QB = 309 * MiB;
constexpr size_t WS_KB = WS_QB + (size_t)MT * 512 * 2;
constexpr size_t WS_VB = WS_KB + 2ull * KVL * 128 * 2;
constexpr size_t WS_Y = WS_VB + 2ull * KVL * 128 * 2;
constexpr size_t WS_Y5 = WS_Y + (size_t)MT * 1536 * 2;
constexpr size_t WS_S5E = WS_Y5 + (size_t)MT * 512 * 2;
constexpr size_t WS_END = WS_S5E + 2ull * 2 * 32 * 260 * 64 * 8;
static_assert(WS_A + (size_t)MT * ZP * 2 <= WS_QB && WS_A + (size_t)MT * 3072 * 2 <= WS_KB && WS_END <= 505 * MiB, "ws map");
constexpr int LDS_BYTES = 147456;

struct Args { const float* in[31]; float* out; unsigned char* ws; };
typedef Args AP;

typedef __bf16 hwbf16x2 __attribute__((ext_vector_type(2)));
__device__ __forceinline__ unsigned pk2(float lo, float hi) { const f32x2 v = {lo, hi}; return __builtin_bit_cast(unsigned, __builtin_convertvector(v, hwbf16x2)); }
__device__ __forceinline__ unsigned f2bf(float f) { return pk2(f, 0.f) & 0xffffu; }
__device__ __forceinline__ float bflo(unsigned w) { return __builtin_bit_cast(float, w << 16); }
__device__ __forceinline__ float bfhi(unsigned w) { return __builtin_bit_cast(float, w & 0xffff0000u); }
__device__ __forceinline__ float bf2f(bf16_t h) { return __builtin_bit_cast(float, ((unsigned)h) << 16); }
__device__ __forceinline__ float wave_sum(float v) {
#pragma unroll
    for (int o = 1; o < 64; o <<= 1) v += __shfl_xor(v, o);
    return v;
}
__device__ __forceinline__ float sigmoidf_(float x) { return __builtin_amdgcn_rcpf(1.f + __expf(-x)); }
__device__ __forceinline__ float siluf_(float x) { return x * sigmoidf_(x); }
__device__ __forceinline__ float gelu_tanh(float x) { const float z = 0.7978845608028654f * (x + 0.044715f * x * x * x); const float t = 1.f - 2.f * __builtin_amdgcn_rcpf(__expf(2.f * z) + 1.f); return 0.5f * x * (1.f + t); }
__device__ __forceinline__ int chunk_row0(int b, int c) { return c < 4 ? MLAT + b * CTXL + 64 * c : b * SEQL + 64 * (c - 4); }
__device__ __forceinline__ int chunk_of(int s, int dir) { return dir == 0 ? s : (s < 4 ? 3 - s : 263 - s); }
#define LDS_WAIT() asm volatile("s_waitcnt lgkmcnt(0)" ::: "memory")
__device__ __forceinline__ int otid() { int t = threadIdx.x; asm volatile("" : "+v"(t)); return t; }

namespace pg8 {
constexpr int BM = 256, BK = 64, HALF = 128, HTB = HALF * BK * 2, STAGE_BYTES = 8 * HTB, NXCD = 8, WGM = 8;
__host__ __device__ __forceinline__ int lds_byte(int r, int c) { const int st = (r >> 4) * 2 + (c >> 5), rr = r & 15, cc = c & 31, ob = rr * 64 + cc * 2; return st * 1024 + (ob ^ (((ob >> 9) & 1) << 5)); }
__host__ __device__ __forceinline__ void stage_rc(int b, int& R, int& C) { const int st = b / 1024, sb = b % 1024, swz = sb ^ (((sb >> 9) & 1) << 5); R = (st >> 1) * 16 + swz / 64; C = (st & 1) * 32 + (swz % 64) / 2; }
__host__ __device__ __forceinline__ int perm32(int rho) { const int n = rho >> 4, i = rho & 15; return 8 * (i >> 2) + 4 * n + (i & 3); }
struct Unit { int pm, pn, kt0, nkt; };
struct Gemm { const bf16_t* A; const bf16_t* Bt; };
struct StaticOrder {
    int nM, nN, nwg, G, c, nkt;
    __device__ void init(int M, int N, int G_, int c_, int nkt_) { nM = M / BM; nN = N / BM; nwg = nM * nN; G = G_; c = c_; nkt = nkt_; }
    __device__ bool next(int i, Unit& u) const {
        const long L = (long)i * G + c; if (L >= nwg) return false;
        int wgid = (int)L; { const int q = nwg / NXCD, r = nwg % NXCD, xcd = wgid % NXCD, off = wgid / NXCD; wgid = (xcd < r ? xcd * (q + 1) : r * (q + 1) + (xcd - r) * q) + off; }
        const int nig = WGM * nN, gid = wgid / nig, fm = gid * WGM, gsz = (nM - fm) < WGM ? (nM - fm) : WGM;
        u.pm = fm + ((wgid % nig) % gsz); u.pn = (wgid % nig) / gsz; u.kt0 = 0; u.nkt = nkt; return true;
    }
};
struct SplitOrder {
    StaticOrder lat; int G, c, nkt, nsl;
    __device__ void init(int G_, int c_, int nkt_, bool ctx) { lat.init(MLAT, 1024, G_, c_, nkt_); G = G_; c = c_; nkt = nkt_; nsl = ctx ? 8 * (nkt_ >> 1) : 0; }
    __device__ bool next(int i, Unit& u) const {
        const long L = (long)i * G + c;
        if (L < lat.nwg) return lat.next(i, u);
        const int sidx = (int)(L - lat.nwg), S = nkt >> 1;
        if (sidx >= nsl) return false;
        const int t = sidx / S; u.pm = 128 + (t & 1); u.pn = t >> 1; u.kt0 = (sidx % S) * 2; u.nkt = 2; return true;
    }
};
__device__ __forceinline__ unsigned cvt_pk_bf16(float lo, float hi) { unsigned r; asm volatile("v_cvt_pk_bf16_f32 %0, %1, %2" : "=v"(r) : "v"(lo), "v"(hi)); return r; }

struct EpiSwiglu {
    bf16_t* O;
    __device__ __forceinline__ void operator()(const f32x4 (&acc)[2][2][4][2], const Unit& u, int wr, int wc, int fr, int fq) const {
        const int row0 = u.pm * BM + wr * 64 + fr, col0 = u.pn * 128 + wc * 32 + 8 * fq;
#pragma unroll
        for (int ai = 0; ai < 2; ++ai)
#pragma unroll
            for (int m = 0; m < 4; ++m) {
                const f32x4 g0 = acc[ai][0][m][0], g1 = acc[ai][0][m][1], u0 = acc[ai][1][m][0], u1 = acc[ai][1][m][1];
                u32x4 w;
                w.x = cvt_pk_bf16(siluf_(g0[0]) * u0[0], siluf_(g0[1]) * u0[1]); w.y = cvt_pk_bf16(siluf_(g0[2]) * u0[2], siluf_(g0[3]) * u0[3]);
                w.z = cvt_pk_bf16(siluf_(g1[0]) * u1[0], siluf_(g1[1]) * u1[1]); w.w = cvt_pk_bf16(siluf_(g1[2]) * u1[2], siluf_(g1[3]) * u1[3]);
                *(u32x4*)(O + (size_t)(row0 + ai * HALF + m * 16) * FFH + col0) = w;
            }
    }
};
struct EpiResid {
    float* h_lat; float* part; const float* gate; float coef;
    __device__ __forceinline__ void operator()(const f32x4 (&acc)[2][2][4][2], const Unit& u, int wr, int wc, int fr, int fq) const {
        const int row0 = u.pm * BM + wr * 64 + fr, col0 = u.pn * BM + wc * 32 + 8 * fq;
        const float* gp = gate + (u.pm < 64 ? 0 : (u.pm < 128 ? NMOD : 2 * NMOD));
        float* hb = (u.pm < 128) ? h_lat + (size_t)row0 * DM : part + ((size_t)(u.kt0 >> 1) * MCTX + (row0 - MLAT)) * DM;
#pragma unroll
        for (int bj = 0; bj < 2; ++bj)
#pragma unroll
            for (int n = 0; n < 2; ++n) {
                const int c = col0 + bj * HALF + 4 * n;
                const f32x4 gv = *(const f32x4*)(gp + c) * coef;
#pragma unroll
                for (int ai = 0; ai < 2; ++ai)
#pragma unroll
                    for (int m = 0; m < 4; ++m) {
                        float* p = hb + (size_t)(ai * HALF + m * 16) * DM + c;
                        const f32x4 dv = gv * acc[ai][bj][m][n];
                        if (u.pm < 128) *(f32x4*)p = *(const f32x4*)p + dv;
                        else *(f32x4*)p = dv;
                    }
            }
    }
};
template <int MODE, int LDC, int NCOL> struct EpiBf {
    bf16_t* O; const bf16_t* Yin; const float* bias;
    __device__ __forceinline__ void operator()(const f32x4 (&acc)[2][2][4][2], const Unit& u, int wr, int wc, int fr, int fq) const {
        const int row0 = u.pm * BM + wr * 64 + fr, col0 = u.pn * BM + wc * 32 + 8 * fq;
#pragma unroll
        for (int bj = 0; bj < 2; ++bj) {
            const int c = col0 + bj * HALF;
            if (c < NCOL) {
                f32x4 b0 = (f32x4){0.f, 0.f, 0.f, 0.f}, b1 = b0;
                if (MODE >= 3) { b0 = *(const f32x4*)(bias + c); b1 = *(const f32x4*)(bias + c + 4); }
#pragma unroll
                for (int ai = 0; ai < 2; ++ai)
#pragma unroll
                    for (int m = 0; m < 4; ++m) {
                        const int r = row0 + ai * HALF + m * 16;
                        f32x4 v0 = acc[ai][bj][m][0], v1 = acc[ai][bj][m][1];
                        if (MODE == 5) {
                            v0 += b0; v1 += b1;
#pragma unroll
                            for (int q = 0; q < 4; ++q) { v0[q] = sigmoidf_(v0[q]); v1[q] = sigmoidf_(v1[q]); }
                        } else if (MODE >= 3) {
                            v0 += b0; v1 += b1;
                            const u32x4 y = (MODE == 3) ? *(const u32x4*)(Yin + (size_t)r * 512 + c) : *(const u32x4*)(O + (size_t)r * LDC + c);
                            v0[0] = sigmoidf_(v0[0]) * bflo(y.x); v0[1] = sigmoidf_(v0[1]) * bfhi(y.x); v0[2] = sigmoidf_(v0[2]) * bflo(y.y); v0[3] = sigmoidf_(v0[3]) * bfhi(y.y);
                            v1[0] = sigmoidf_(v1[0]) * bflo(y.z); v1[1] = sigmoidf_(v1[1]) * bfhi(y.z); v1[2] = sigmoidf_(v1[2]) * bflo(y.w); v1[3] = sigmoidf_(v1[3]) * bfhi(y.w);
                        }
                        u32x4 w; w.x = cvt_pk_bf16(v0[0], v0[1]); w.y = cvt_pk_bf16(v0[2], v0[3]); w.z = cvt_pk_bf16(v1[0], v1[1]); w.w = cvt_pk_bf16(v1[2], v1[3]);
                        *(u32x4*)(O + (size_t)r * LDC + c) = w;
                    }
            }
        }
    }
};

struct EpiBranch {
    const bf16_t* G; bf16_t* Mo;
    __device__ __forceinline__ void operator()(const f32x4 (&acc)[2][2][4][2], const Unit& u, int wr, int wc, int fr, int fq) const {
        const int br = u.pn >> 2, row0 = u.pm * BM + wr * 64 + fr, col0 = (u.pn & 3) * BM + wc * 32 + 8 * fq;
#pragma unroll
        for (int bj = 0; bj < 2; ++bj) {
            const int c = col0 + bj * HALF;
#pragma unroll
            for (int ai = 0; ai < 2; ++ai)
#pragma unroll
                for (int m = 0; m < 4; ++m) {
                    const int r = row0 + ai * HALF + m * 16;
                    const u32x4 g = *(const u32x4*)(G + (size_t)r * 3072 + br * 1024 + c);
                    f32x4 v0 = acc[ai][bj][m][0], v1 = acc[ai][bj][m][1];
                    v0[0] *= bflo(g.x); v0[1] *= bfhi(g.x); v0[2] *= bflo(g.y); v0[3] *= bfhi(g.y); v1[0] *= bflo(g.z); v1[1] *= bfhi(g.z); v1[2] *= bflo(g.w); v1[3] *= bfhi(g.w);
                    bf16_t* mp = Mo + (size_t)r * 1024 + c;
                    if (br > 0) { const u32x4 p = *(const u32x4*)mp;
                        v0[0] += bflo(p.x); v0[1] += bfhi(p.x); v0[2] += bflo(p.y); v0[3] += bfhi(p.y); v1[0] += bflo(p.z); v1[1] += bfhi(p.z); v1[2] += bflo(p.w); v1[3] += bfhi(p.w); }
                    u32x4 w; w.x = cvt_pk_bf16(v0[0], v0[1]); w.y = cvt_pk_bf16(v0[2], v0[3]); w.z = cvt_pk_bf16(v1[0], v1[1]); w.w = cvt_pk_bf16(v1[2], v1[3]);
                    *(u32x4*)mp = w;
                }
        }
    }
};
struct BranchOrder {
    StaticOrder tl;
    __device__ void init(int M, int G_, int c_, int nkt_) { tl.init(M, 1024, G_, c_, nkt_); }
    __device__ bool next(int i, Unit& u) const { if (!tl.next(i / 3, u)) return false; u.pn += 4 * (i % 3); return true; }
};
template <class EpiT, class Sched, int K_, int LDA, int LDB, int ASH, int AKOFF>
__device__ __forceinline__ void gemm_phase(LAS unsigned char* lds, const Gemm g, const Sched& S, const EpiT& E) {
    const int tid = otid(), wid = __builtin_amdgcn_readfirstlane(tid >> 6), lane = tid & 63, wr = wid >> 2, wc = wid & 3, fr = lane & 15, fq = lane >> 4;
    constexpr int nt = K_ / BK;
    unsigned voffA[2], voffB[2];
#pragma unroll
    for (int i = 0; i < 2; ++i) { int R, C; stage_rc(tid * 16 + i * 8192, R, C); const int Rb = (R & ~31) + perm32(R & 31);
        voffA[i] = (unsigned)(R * LDA + C) * 2u; voffB[i] = (unsigned)(Rb * LDB + C) * 2u; }
    const size_t kstep = (size_t)(BK * 2);
    constexpr size_t hsA = (size_t)HALF * LDA * 2, hsB = (size_t)HALF * LDB * 2;
    constexpr size_t tsA = 2 * hsA, tsB = 2 * hsB;
    const unsigned ldsw = (unsigned)wid * 1024u;
    const int aoff = lds_byte(wr * 64 + fr, fq * 8), boff = lds_byte(wc * 32 + fr, fq * 8);
#define PG8_SA(b, h) (((b) * 2 + (h)) * HTB)
#define PG8_SB(b, h) ((4 + (b) * 2 + (h)) * HTB)
#define PG8_STAGE(bufoff, gbase, voff) do { _Pragma("unroll") for (int _i = 0; _i < 2; ++_i) \
        __builtin_amdgcn_global_load_lds((const unsigned*)((const char*)(gbase) + (voff)[_i]), (LAS unsigned*)(lds + (bufoff) + ldsw + _i * 8192), 16, 0, 0); } while (0)
#define PG8_LDA(dst, b, h) do { _Pragma("unroll") for (int m = 0; m < 4; ++m) _Pragma("unroll") for (int k = 0; k < 2; ++k) dst[m][k] = *(const LAS bf16x8*)(lds + PG8_SA(b, h) + aoff + m * 2048 + k * 1024); } while (0)
#define PG8_LDB(dst, b, h) do { _Pragma("unroll") for (int n = 0; n < 2; ++n) _Pragma("unroll") for (int k = 0; k < 2; ++k) dst[n][k] = *(const LAS bf16x8*)(lds + PG8_SB(b, h) + boff + n * 2048 + k * 1024); } while (0)
#define PG8_MMA(ai, bj, At, Bt) do { __builtin_amdgcn_s_setprio(1); _Pragma("unroll") for (int m = 0; m < 4; ++m) _Pragma("unroll") for (int n = 0; n < 2; ++n) _Pragma("unroll") for (int k = 0; k < 2; ++k) \
        acc[ai][bj][m][n] = __builtin_amdgcn_mfma_f32_16x16x32_bf16(Bt[n][k], At[m][k], acc[ai][bj][m][n], 0, 0, 0); __builtin_amdgcn_s_setprio(0); } while (0)
#define PG8_WAIT_V(n) asm volatile("s_waitcnt vmcnt(" #n ")" ::: "memory")
#define PG8_WAIT_L(n) asm volatile("s_waitcnt lgkmcnt(" #n ")" ::: "memory")
#define PG8_BAR __builtin_amdgcn_s_barrier()
#define PG8_SCHED __builtin_amdgcn_sched_barrier(0)
#define PG8_UA(u) ((const char*)g.A + (size_t)(u).pm * tsA + (size_t)(((u).pn >> ASH) * AKOFF) * 2 + (size_t)(u).kt0 * (BK * 2))
#define PG8_UB(u) ((const char*)g.Bt + (size_t)(u).pn * tsB + (size_t)(u).kt0 * (BK * 2))
    Unit cur, nxt; int ui = 0;
    if (!S.next(0, cur)) return;
    f32x4 acc[2][2][4][2];
#pragma unroll
    for (int a = 0; a < 2; ++a)
#pragma unroll
        for (int b = 0; b < 2; ++b)
#pragma unroll
            for (int m = 0; m < 4; ++m)
#pragma unroll
                for (int n = 0; n < 2; ++n) acc[a][b][m][n] = (f32x4){0.f, 0.f, 0.f, 0.f};
    bf16x8 At[4][2], B0[2][2], B1[2][2];
    const char* cA = PG8_UA(cur); const char* cB = PG8_UB(cur);
    PG8_STAGE(PG8_SB(0, 0), cB, voffB); PG8_STAGE(PG8_SB(0, 1), cB + hsB, voffB); PG8_STAGE(PG8_SA(0, 0), cA, voffA); PG8_STAGE(PG8_SA(0, 1), cA + hsA, voffA);
    if (wr == 1) PG8_BAR;
    PG8_WAIT_V(2); PG8_BAR;
    PG8_STAGE(PG8_SB(1, 0), cB + kstep, voffB); PG8_STAGE(PG8_SA(1, 0), cA + kstep, voffA); PG8_STAGE(PG8_SB(1, 1), cB + hsB + kstep, voffB);
    PG8_WAIT_V(6); PG8_BAR;
    for (;;) {
        const bool has_next = S.next(ui + 1, nxt);
        const char* nA = has_next ? PG8_UA(nxt) : cA; const char* nB = has_next ? PG8_UB(nxt) : cB;
        const int cnt = cur.nkt;
        for (int t = 0; t < cnt; t += 2) {
            const bool last = (t == cnt - 2);
            const char* a1 = cA + (size_t)(t + 1) * kstep;
            const char* a2 = last ? nA : cA + (size_t)(t + 2) * kstep; const char* b2 = last ? nB : cB + (size_t)(t + 2) * kstep;
            const char* a3 = a2 + kstep; const char* b3 = b2 + kstep;
            PG8_LDB(B0, 0, 0); PG8_LDB(B1, 0, 1); PG8_SCHED; PG8_LDA(At, 0, 0); PG8_STAGE(PG8_SA(1, 1), a1 + hsA, voffA);
            PG8_WAIT_V(8); PG8_WAIT_L(0); PG8_BAR; PG8_MMA(0, 0, At, B0); PG8_MMA(0, 1, At, B1); PG8_BAR; PG8_SCHED;
            PG8_LDA(At, 0, 1); PG8_STAGE(PG8_SB(0, 0), b2, voffB); PG8_STAGE(PG8_SB(0, 1), b2 + hsB, voffB); PG8_STAGE(PG8_SA(0, 0), a2, voffA);
            PG8_WAIT_V(8); PG8_WAIT_L(0); PG8_BAR; PG8_MMA(1, 0, At, B0); PG8_MMA(1, 1, At, B1); PG8_BAR; PG8_SCHED;
            PG8_LDB(B0, 1, 0); PG8_LDB(B1, 1, 1); PG8_SCHED; PG8_LDA(At, 1, 0); PG8_STAGE(PG8_SA(0, 1), a2 + hsA, voffA);
            PG8_WAIT_V(8); PG8_WAIT_L(0); PG8_BAR; PG8_MMA(0, 0, At, B0); PG8_MMA(0, 1, At, B1); PG8_BAR; PG8_SCHED;
            PG8_LDA(At, 1, 1); PG8_STAGE(PG8_SB(1, 0), b3, voffB); PG8_STAGE(PG8_SB(1, 1), b3 + hsB, voffB); PG8_STAGE(PG8_SA(1, 0), a3, voffA);
            PG8_WAIT_V(8); PG8_WAIT_L(0); PG8_BAR; PG8_MMA(1, 0, At, B0); PG8_MMA(1, 1, At, B1); PG8_BAR; PG8_SCHED;
        }
        if (wr == 0) PG8_BAR;
        E(acc, cur, wr, wc, fr, fq);
        if (!has_next) break;
#pragma unroll
        for (int a = 0; a < 2; ++a)
#pragma unroll
            for (int b = 0; b < 2; ++b)
#pragma unroll
                for (int m = 0; m < 4; ++m)
#pragma unroll
                    for (int n = 0; n < 2; ++n) acc[a][b][m][n] = (f32x4){0.f, 0.f, 0.f, 0.f};
        cur = nxt; cA = nA; cB = nB; ++ui;
        if (wr == 1) PG8_BAR;
    }
    PG8_WAIT_V(0);
    PG8_BAR;
#undef PG8_SA
#undef PG8_SB
#undef PG8_STAGE
#undef PG8_LDA
#undef PG8_LDB
#undef PG8_MMA
#undef PG8_WAIT_V
#undef PG8_WAIT_L
#undef PG8_BAR
#undef PG8_SCHED
#undef PG8_UA
#undef PG8_UB
}
}

namespace attn_body {
using bf16 = __hip_bfloat16;
using s16x4 = __attribute__((ext_vector_type(4))) short;
using f32x16 = __attribute__((ext_vector_type(16))) float;
constexpr int D = 64, NW = 8, QBLK = 32, QB = QBLK * NW, KVBLK = 64;
constexpr int QP = 512, KP = 128, VP = 128, OP = 1536;
__device__ __forceinline__ int crow(int r, int hi) { return (r & 3) + 8 * (r >> 2) + 4 * hi; }
#define SBAR() __builtin_amdgcn_sched_barrier(0)
constexpr int NSLOT = 3, SLOTB = 8192;
constexpr int LDS_K = 0, LDS_V = NSLOT * SLOTB, LDS_WS = 2 * NSLOT * SLOTB, LDS_OST = LDS_WS + NW * 64 * 4, ALDS_BYTES = LDS_OST + NW * 4096;
constexpr float C2 = 0.125f * 1.4426950408889634f;
__device__ __forceinline__ void glds16(const void* gsrc, unsigned lds_dst) { unsigned keep;
  asm volatile("s_mov_b32 %0, m0\n\ts_mov_b32 m0, %2\n\ts_nop 0\n\tglobal_load_lds_dwordx4 %1, off\n\ts_mov_b32 m0, %0" : "=&s"(keep) : "v"(gsrc), "s"(lds_dst) : "memory"); }
__device__ __forceinline__ float max3f(float a, float b, float c) { float r; asm("v_max3_f32 %0, %1, %2, %3" : "=v"(r) : "v"(a), "v"(b), "v"(c)); return r; }
__device__ __forceinline__ float max2f(float a, float b) { float r; asm("v_max_f32_e32 %0, %1, %2" : "=v"(r) : "v"(a), "v"(b)); return r; }
__device__ __forceinline__ float fadd_s(float a, float b) { float r; asm("v_add_f32_e32 %0, %1, %2" : "=v"(r) : "v"(a), "v"(b)); return r; }
__device__ __forceinline__ float fsub_s(float a, float b) { float r; asm("v_sub_f32_e32 %0, %1, %2" : "=v"(r) : "v"(a), "v"(b)); return r; }
typedef float f32x2_t __attribute__((ext_vector_type(2))); typedef __bf16 bf16x2_t __attribute__((ext_vector_type(2)));
__device__ __forceinline__ unsigned cvtpk_s(float lo, float hi) { f32x2_t v = {lo, hi}; bf16x2_t b = __builtin_convertvector(v, bf16x2_t); return __builtin_bit_cast(unsigned, b); }
#define WAIT_BAR(N) asm volatile("s_waitcnt vmcnt(" #N ") lgkmcnt(0)\n\ts_barrier" ::: "memory")
__device__ __forceinline__ void qkt(f32x16& p0, f32x16& p1, const char* Kslot, const bf16x8* qr, const f32x16& negm, int r32, int hi) {
  const char* kb = Kslot + hi * 1024 + r32 * 16;
  #pragma unroll
  for (int d0 = 0; d0 < 4; ++d0) {
    const bf16x8 b0 = *reinterpret_cast<const bf16x8*>(kb + d0 * 2048);
    const bf16x8 b1 = *reinterpret_cast<const bf16x8*>(kb + d0 * 2048 + 512);
    if (d0 == 0) { p0 = __builtin_amdgcn_mfma_f32_32x32x16_bf16(b0, qr[0], negm, 0, 0, 0); p1 = __builtin_amdgcn_mfma_f32_32x32x16_bf16(b1, qr[0], negm, 0, 0, 0); }
    else { p0 = __builtin_amdgcn_mfma_f32_32x32x16_bf16(b0, qr[d0], p0, 0, 0, 0); p1 = __builtin_amdgcn_mfma_f32_32x32x16_bf16(b1, qr[d0], p1, 0, 0, 0); } }
}
typedef __attribute__((address_space(3))) const char* lds_cptr;
typedef short v4i16_t __attribute__((ext_vector_type(4)));
__device__ __forceinline__ void kload8(bf16x8* kf, lds_cptr kp) {
  kf[0] = *(const LAS bf16x8*)(kp);        kf[1] = *(const LAS bf16x8*)(kp + 512);
  kf[2] = *(const LAS bf16x8*)(kp + 2048); kf[3] = *(const LAS bf16x8*)(kp + 2560);
  kf[4] = *(const LAS bf16x8*)(kp + 4096); kf[5] = *(const LAS bf16x8*)(kp + 4608);
  kf[6] = *(const LAS bf16x8*)(kp + 6144); kf[7] = *(const LAS bf16x8*)(kp + 6656);
}
__device__ __forceinline__ void kload2(bf16x8* kf, lds_cptr kp, int j) { kf[2 * j] = *(const LAS bf16x8*)(kp + j * 2048); kf[2 * j + 1] = *(const LAS bf16x8*)(kp + j * 2048 + 512); }
__device__ __forceinline__ s16x4 vtr(lds_cptr p) { return __builtin_bit_cast(s16x4, __builtin_amdgcn_ds_read_tr16_b64_v4i16((LAS v4i16_t*)p)); }
__device__ __forceinline__ float rowmax(const f32x16& p0, const f32x16& p1) {
  float a = max3f(p0[0], p0[1], p1[0]), b = max3f(p0[2], p0[3], p1[1]); a = max3f(a, p1[2], p1[3]);
  #pragma unroll
  for (int r = 4; r < 16; r += 4) { a = max3f(a, p0[r], p0[r + 1]); b = max3f(b, p0[r + 2], p0[r + 3]); a = max3f(a, p1[r], p1[r + 1]); b = max3f(b, p1[r + 2], p1[r + 3]); }
  const float m = max2f(a, b);
  auto rr = __builtin_amdgcn_permlane32_swap(__float_as_uint(m), __float_as_uint(m), false, false);
  return max2f(__uint_as_float(rr[0]), __uint_as_float(rr[1]));
}
__device__ __forceinline__ void pv(f32x16* o, int vb, bf16x8 pa0, bf16x8 pa1, bf16x8 pa2, bf16x8 pa3) {
  #pragma unroll
  for (int d0 = 0; d0 < 2; ++d0) { s16x4 lo[4], hi[4];
    #pragma unroll
    for (int ks = 0; ks < 4; ++ks) {
      asm volatile("ds_read_b64_tr_b16 %0,%1 offset:%c2" : "=&v"(lo[ks]) : "v"(vb), "i"(d0 * 4096 + ks * 1024) : "memory");
      asm volatile("ds_read_b64_tr_b16 %0,%1 offset:%c2" : "=&v"(hi[ks]) : "v"(vb), "i"(d0 * 4096 + ks * 1024 + 512) : "memory"); }
    asm volatile("s_waitcnt lgkmcnt(0)" ::: "memory"); SBAR();
    #define PK(k) (bf16x8){lo[k][0], lo[k][1], lo[k][2], lo[k][3], hi[k][0], hi[k][1], hi[k][2], hi[k][3]}
    o[d0] = __builtin_amdgcn_mfma_f32_32x32x16_bf16(pa0, PK(0), o[d0], 0, 0, 0);
    o[d0] = __builtin_amdgcn_mfma_f32_32x32x16_bf16(pa1, PK(1), o[d0], 0, 0, 0);
    o[d0] = __builtin_amdgcn_mfma_f32_32x32x16_bf16(pa2, PK(2), o[d0], 0, 0, 0);
    o[d0] = __builtin_amdgcn_mfma_f32_32x32x16_bf16(pa3, PK(3), o[d0], 0, 0, 0);
    #undef PK
  }
}
template <int THRL> __device__ __forceinline__ void attn_unit(const bf16* Qu, const bf16* __restrict__ Kh, const bf16* __restrict__ Vh, bf16* Ou, const int NT, char* shm) {
  const int tid = otid(), lane = tid & 63, r32 = lane & 31, hi = lane >> 5; const int wid = __builtin_amdgcn_readfirstlane(tid >> 6);
  const bf16* Qw = Qu + (long)(wid * QBLK) * QP;
  const unsigned lds0 = (unsigned)(uintptr_t)shm;
  float* wsf = (float*)(shm + LDS_WS) + wid * 64;
  const bf16* ksrc = Kh + (long)lane * KP + wid * 8;
  const bf16* vsrc = Vh + (long)(16 * (wid & 3) + (lane >> 2)) * VP + (wid >> 2) * 32 + (lane & 3) * 8;
  const unsigned kdst = lds0 + LDS_K + wid * 1024, vdst = lds0 + LDS_V + wid * 1024;
  #define DMA_K(t, slot) glds16(ksrc + (long)(t) * KVBLK * KP, (unsigned)__builtin_amdgcn_readfirstlane(kdst + (slot)))
  #define DMA_V(t, slot) glds16(vsrc + (long)(t) * KVBLK * VP, (unsigned)__builtin_amdgcn_readfirstlane(vdst + (slot)))
  const int vb0 = (int)(lds0 + LDS_V) + ((lane >> 4) & 1) * 32 + (lane & 3) * 8 + (4 * hi + ((lane & 15) >> 2)) * 64;
  const char* Kbase = shm + LDS_K; bf16x8 kf[8];
  const lds_cptr shm3 = (lds_cptr)shm; const lds_cptr kp0 = shm3 + LDS_K + hi * 1024 + r32 * 16; const lds_cptr vp0 = shm3 + LDS_V + ((lane >> 4) & 1) * 32 + (lane & 3) * 8 + (4 * hi + ((lane & 15) >> 2)) * 64;
  DMA_K(0, 0); DMA_V(0, 0); DMA_K(1, SLOTB);
  bf16x8 qr[4];
  #pragma unroll
  for (int d0 = 0; d0 < 4; ++d0) qr[d0] = *reinterpret_cast<const bf16x8*>(&Qw[(long)r32 * QP + d0 * 16 + hi * 8]);
  float mhat = 0.f, l_reg = 0.f; f32x16 o[2]; o[0] = f32x16{}; o[1] = f32x16{}; f32x16 negm = f32x16{}; asm volatile("" : "+v"(negm));
  bool resc = false;
  #define START(P0, P1) do { const float rm = rowmax(P0, P1); resc = false; \
    { const float dl = rm; mhat = fadd_s(mhat, dl); \
      _Pragma("unroll") for (int r = 0; r < 16; ++r) { P0[r] = fsub_s(P0[r], dl); P1[r] = fsub_s(P1[r], dl); } \
      _Pragma("unroll") for (int r = 0; r < 16; ++r) negm[r] = -mhat; asm volatile("" : "+v"(negm)); } \
    _Pragma("unroll") for (int r = 0; r < 16; ++r) P0[r] = __builtin_amdgcn_exp2f(P0[r]); } while (0)
  #define RESC() do { if (resc) { asm volatile("s_waitcnt lgkmcnt(0)" ::: "memory"); \
      _Pragma("unroll") for (int d_ = 0; d_ < 2; ++d_) _Pragma("unroll") for (int r = 0; r < 16; ++r) o[d_][r] *= wsf[crow(r, hi)]; } } while (0)
  f32x16 pA0, pA1, pB0, pB1;
  int sl_prev = 0, sl_cur = 0, sl_next = SLOTB;
  #define ROT() do { sl_prev = sl_cur; sl_cur = sl_next; sl_next = (sl_next == (NSLOT - 1) * SLOTB) ? 0 : sl_next + SLOTB; } while (0)
  DMA_K(2, 2 * SLOTB);
  WAIT_BAR(3);
  qkt(pA0, pA1, Kbase, qr, negm, r32, hi); asm volatile("s_nop 15\n\ts_nop 7" : "+v"(pA0), "+v"(pA1));
  START(pA0, pA1);
  _Pragma("unroll") for (int r = 0; r < 16; ++r) pA1[r] = __builtin_amdgcn_exp2f(pA1[r]);
  WAIT_BAR(0);
  DMA_K(3, 0); DMA_V(1, SLOTB);
  ROT();
  kload8(kf, kp0 + sl_cur);
  WAIT_BAR(2);
  s16x4 vlo[8], vhi[8]; u32x4 pw0, pw1, pw2, pw3;
  #define PKW(P, B) cvtpk_s(P[B], P[B + 1])
  #define PAF(k) __builtin_bit_cast(bf16x8, pw##k)
  #define VFR(i) (bf16x8){vlo[i][0], vlo[i][1], vlo[i][2], vlo[i][3], vhi[i][0], vhi[i][1], vhi[i][2], vhi[i][3]}
  #define PIN(x) asm volatile("" : "+v"(x))
  #define MX3(a, b, c) __builtin_fmaxf(__builtin_fmaxf((a), (b)), (c))
  #define GAPA(MF, A0, A1, A2, A3, W0, W1, PW) do { MF; sacc += A0; sacc += A1; sacc += A2; sacc += A3; PIN(sacc); W0; W1; PIN(PW); SBAR(); } while (0)
  #define EX(v) __builtin_amdgcn_exp2f(v)
  #define GAPB(MF, X, B) do { MF; X[B] = EX(X[B]); X[B + 1] = EX(X[B + 1]); X[B + 2] = EX(X[B + 2]); X[B + 3] = EX(X[B + 3]); PIN(X); SBAR(); } while (0)
  #define VRD(i) do { vlo[i] = vtr(vp_ + (((i) >> 2) * 4096 + ((i) & 3) * 1024)); vhi[i] = vtr(vp_ + (((i) >> 2) * 4096 + ((i) & 3) * 1024 + 512)); } while (0)
  #define KRD(G, j) do { if (G) { kload2(kf, kp0 + sl_next, j); SBAR(); } } while (0)
  #define STEP(C0, C1, P0, P1, t, GK, GV, GL) do { SBAR(); \
    const lds_cptr vp_ = vp0 + sl_prev; \
    VRD(0); SBAR(); float sacc = (P0[0] + P0[1]); \
    GAPA(C0 = __builtin_amdgcn_mfma_f32_32x32x16_bf16(kf[0], qr[0], negm, 0, 0, 0), P0[2], P0[3], P0[4], P0[5],     pw0[0] = PKW(P0, 0), pw0[1] = PKW(P0, 2), pw0); \
    VRD(4); SBAR(); GAPA(C1 = __builtin_amdgcn_mfma_f32_32x32x16_bf16(kf[1], qr[0], negm, 0, 0, 0), P0[6], P0[7], P0[8], P0[9],     pw0[2] = PKW(P0, 4), pw0[3] = PKW(P0, 6), pw0); \
    VRD(1); SBAR(); GAPA(C0 = __builtin_amdgcn_mfma_f32_32x32x16_bf16(kf[2], qr[1], C0, 0, 0, 0),   P0[10], P0[11], P0[12], P0[13], pw1[0] = PKW(P0, 8), pw1[1] = PKW(P0, 10), pw1); \
    VRD(5); SBAR(); GAPA(C1 = __builtin_amdgcn_mfma_f32_32x32x16_bf16(kf[3], qr[1], C1, 0, 0, 0),   P0[14], P0[15], P1[0], P1[1],   pw1[2] = PKW(P0, 12), pw1[3] = PKW(P0, 14), pw1); \
    VRD(2); SBAR(); GAPA(C0 = __builtin_amdgcn_mfma_f32_32x32x16_bf16(kf[4], qr[2], C0, 0, 0, 0),   P1[2], P1[3], P1[4], P1[5],     pw2[0] = PKW(P1, 0), pw2[1] = PKW(P1, 2), pw2); \
    VRD(6); SBAR(); GAPA(C1 = __builtin_amdgcn_mfma_f32_32x32x16_bf16(kf[5], qr[2], C1, 0, 0, 0),   P1[6], P1[7], P1[8], P1[9],     pw2[2] = PKW(P1, 4), pw2[3] = PKW(P1, 6), pw2); \
    VRD(3); SBAR(); GAPA(C0 = __builtin_amdgcn_mfma_f32_32x32x16_bf16(kf[6], qr[3], C0, 0, 0, 0),   P1[10], P1[11], P1[12], P1[13], pw3[0] = PKW(P1, 8), pw3[1] = PKW(P1, 10), pw3); \
    VRD(7); SBAR(); GAPA(C1 = __builtin_amdgcn_mfma_f32_32x32x16_bf16(kf[7], qr[3], C1, 0, 0, 0),   P1[14], P1[15], 0.f, 0.f,       pw3[2] = PKW(P1, 12), pw3[3] = PKW(P1, 14), pw3); \
    l_reg += sacc; \
    if (GK) { DMA_K((t) + 3, sl_cur); } if (GV) { DMA_V((t) + 1, sl_next); } \
    { float a = MX3(C0[0], C0[1], C1[0]), b = MX3(C0[2], C0[3], C1[1]); a = MX3(a, C1[2], C1[3]); \
      _Pragma("unroll") for (int r = 4; r < 16; r += 4) { a = MX3(a, C0[r], C0[r + 1]); b = MX3(b, C0[r + 2], C0[r + 3]); a = MX3(a, C1[r], C1[r + 1]); b = MX3(b, C1[r + 2], C1[r + 3]); } \
      float rm = __builtin_fmaxf(a, b); { auto rr = __builtin_amdgcn_permlane32_swap(__float_as_uint(rm), __float_as_uint(rm), false, false); rm = __builtin_fmaxf(__uint_as_float(rr[0]), __uint_as_float(rr[1])); } \
      resc = false; \
      if (__builtin_expect(__any(rm > (float)THRL), 0)) { const float dl = __builtin_fmaxf(rm, 0.f); mhat += dl; \
        _Pragma("unroll") for (int r = 0; r < 16; ++r) { C0[r] -= dl; C1[r] -= dl; } \
        _Pragma("unroll") for (int r = 0; r < 16; ++r) negm[r] = -mhat; asm volatile("" : "+v"(negm)); \
        const float f = __builtin_amdgcn_exp2f(-dl); l_reg *= f; if (hi == 0) wsf[r32] = f; resc = true; } } \
    SBAR(); \
    GAPB(o[0] = __builtin_amdgcn_mfma_f32_32x32x16_bf16(PAF(0), VFR(0), o[0], 0, 0, 0), C0, 0); \
    GAPB(o[1] = __builtin_amdgcn_mfma_f32_32x32x16_bf16(PAF(0), VFR(4), o[1], 0, 0, 0), C0, 4); \
    KRD(GL, 0); GAPB(o[0] = __builtin_amdgcn_mfma_f32_32x32x16_bf16(PAF(1), VFR(1), o[0], 0, 0, 0), C0, 8); \
    KRD(GL, 1); GAPB(o[1] = __builtin_amdgcn_mfma_f32_32x32x16_bf16(PAF(1), VFR(5), o[1], 0, 0, 0), C0, 12); \
    KRD(GL, 2); GAPB(o[0] = __builtin_amdgcn_mfma_f32_32x32x16_bf16(PAF(2), VFR(2), o[0], 0, 0, 0), C1, 0); \
    KRD(GL, 3); GAPB(o[1] = __builtin_amdgcn_mfma_f32_32x32x16_bf16(PAF(2), VFR(6), o[1], 0, 0, 0), C1, 4); \
    GAPB(o[0] = __builtin_amdgcn_mfma_f32_32x32x16_bf16(PAF(3), VFR(3), o[0], 0, 0, 0), C1, 8); \
    GAPB(o[1] = __builtin_amdgcn_mfma_f32_32x32x16_bf16(PAF(3), VFR(7), o[1], 0, 0, 0), C1, 12); \
    } while (0)
  int t = 1;
  for (; t + 5 < NT; t += 2) {
    STEP(pB0, pB1, pA0, pA1, t, true, true, true);     WAIT_BAR(2); RESC(); ROT();
    STEP(pA0, pA1, pB0, pB1, t + 1, true, true, true); WAIT_BAR(2); RESC(); ROT();
  }
  #define ENDW(tt) do { if ((tt) + 3 < NT) { WAIT_BAR(2); } else if ((tt) + 2 < NT) { WAIT_BAR(1); } else { WAIT_BAR(0); } } while (0)
  for (; t + 1 < NT; t += 2) {
    STEP(pB0, pB1, pA0, pA1, t, (t + 3 < NT), (t + 1 < NT), (t + 1 < NT));         ENDW(t);     RESC(); ROT();
    STEP(pA0, pA1, pB0, pB1, t + 1, (t + 4 < NT), (t + 2 < NT), (t + 2 < NT));     ENDW(t + 1); RESC(); ROT();
  }
  STEP(pB0, pB1, pA0, pA1, NT - 1, false, false, false); RESC();
  { float sacc = pB0[0] + pB0[1]; _Pragma("unroll") for (int r = 2; r < 16; ++r) sacc += pB0[r]; _Pragma("unroll") for (int r = 0; r < 16; ++r) sacc += pB1[r]; l_reg += sacc;
    pw0 = (u32x4){PKW(pB0, 0), PKW(pB0, 2), PKW(pB0, 4), PKW(pB0, 6)}; pw1 = (u32x4){PKW(pB0, 8), PKW(pB0, 10), PKW(pB0, 12), PKW(pB0, 14)}; pw2 = (u32x4){PKW(pB1, 0), PKW(pB1, 2), PKW(pB1, 4), PKW(pB1, 6)}; pw3 = (u32x4){PKW(pB1, 8), PKW(pB1, 10), PKW(pB1, 12), PKW(pB1, 14)};
    SBAR(); pv(o, vb0 + sl_cur, PAF(0), PAF(1), PAF(2), PAF(3)); }
  #undef PKW
  #undef PAF
  #undef VFR
  #undef PIN
  #undef MX3
  #undef GAPA
  #undef GAPB
  #undef EX
  #undef VRD
  #undef KRD
  #undef STEP
  #undef ENDW
  { auto rr = __builtin_amdgcn_permlane32_swap(__float_as_uint(l_reg), __float_as_uint(l_reg), false, false); l_reg = __uint_as_float(rr[0]) + __uint_as_float(rr[1]); }
  if (hi == 0) wsf[32 + r32] = l_reg; asm volatile("s_waitcnt lgkmcnt(0)" ::: "memory");
  float rli[16];
  #pragma unroll
  for (int r = 0; r < 16; ++r) rli[r] = __builtin_amdgcn_rcpf(wsf[32 + crow(r, hi)]);
  bf16* Ow = Ou + (long)(wid * QBLK) * OP;
  { bf16* stg = (bf16*)(shm + LDS_OST) + wid * 2048;
    #pragma unroll
    for (int r = 0; r < 16; ++r) { const int orow = crow(r, hi);
      #pragma unroll
      for (int d0 = 0; d0 < 2; ++d0) stg[orow * 64 + d0 * 32 + r32] = __float2bfloat16(o[d0][r] * rli[r]); }
    asm volatile("s_waitcnt lgkmcnt(0)" ::: "memory");
    #pragma unroll
    for (int i = 0; i < 4; ++i) { const int row = i * 8 + (lane >> 3), ch = lane & 7; const u32x4 v = *(const u32x4*)(stg + row * 64 + ch * 8); *(u32x4*)(Ow + (long)row * OP + ch * 8) = v; } }
  asm volatile("s_waitcnt lgkmcnt(0)\n\ts_barrier" ::: "memory");
  #undef DMA_K
  #undef DMA_V
  #undef START
  #undef RESC
  #undef ROT
}
#undef SBAR
#undef WAIT_BAR
}

__device__ __forceinline__ f32x4 mm_tile(const LAS bf16_t* X, int ldx, const LAS bf16_t* Y, int ldy, int K, int lane, f32x4 acc) {
    const LAS bf16_t* xp = X + (lane & 15) * ldx + (lane >> 4) * 8;
    const LAS bf16_t* yp = Y + (lane & 15) * ldy + (lane >> 4) * 8;
    for (int k = 0; k < K; k += 32) {
        const bf16x8 a = *(const LAS bf16x8*)(xp + k), b = *(const LAS bf16x8*)(yp + k);
        acc = __builtin_amdgcn_mfma_f32_16x16x32_bf16(a, b, acc, 0, 0, 0);
    }
    return acc;
}

__device__ __forceinline__ int win_map(int n) { return n < 768 ? n + 2080 : (n < 1792 ? n - 768 : (n < 2816 ? n - 736 : (n < 2848 ? n - 1792 : -1))); }
__device__ __forceinline__ const float* wsrc_ptr(const AP& a, int mat, int li, int k, int n, size_t& rs) {
    switch (mat) {
        case 0: case 1: { const int pn = n >> 8, w = n & 255; const float* W = (w < 128) ? a.in[7] : a.in[8]; rs = FFH; return W + ((size_t)(li * 2 + mat) * 1024 + k) * FFH + pn * 128 + (w & 127); }
        case 2: case 3: rs = 1024; return a.in[9] + ((size_t)(li * 2 + mat - 2) * FFH + k) * 1024 + n;
        case 4: { const int o = win_map(n); rs = ZP; return o < 0 ? nullptr : a.in[10] + ((size_t)li * 1024 + k) * ZP + o; }
        case 5: rs = 3072; return a.in[26] + ((size_t)li * 1024 + k) * 3072 + n;
        case 6: rs = 1024; return a.in[28] + (((size_t)li * 3 + (n >> 10)) * 512 + k) * 1024 + (n & 1023);
        case 7: rs = 1024; return a.in[29] + ((size_t)li * 1024 + (k & 1023)) * 1024 + n;
        default: rs = 512; return a.in[22] + ((size_t)li * 512 + k) * 512 + n;
    }
}
__device__ __forceinline__ void tables_phase(const AP& args, LAS unsigned char* lds) {
    const int tid = otid(), G = gridDim.x;
    unsigned char* ws = args.ws;
    const int gt = blockIdx.x * 512 + tid, NTH = G * 512;
    {
        LAS float* sv = (LAS float*)lds;
        LAS float* red = sv + 3072;
        for (int i = tid; i < 3072; i += 512) { const int g = i >> 10, k = i & 1023; const float v = g < 2 ? args.in[1][g * 1024 + k] : args.in[3][k]; sv[i] = siluf_(v); }
        __syncthreads();
        for (int it = blockIdx.x; it < 288; it += G) {
            const int l = it / 144, c0 = (it % 144) * 64, col = tid & 63, ks = tid >> 6;
            const float* W = args.in[4] + (size_t)l * 1024 * NMOD + c0 + col;
            float a0 = 0.f, a1 = 0.f, a2 = 0.f;
#pragma unroll 16
            for (int k = ks * 128; k < ks * 128 + 128; ++k) { const float w = W[(size_t)k * NMOD]; a0 += sv[k] * w; a1 += sv[1024 + k] * w; a2 += sv[2048 + k] * w; }
            red[(ks * 64 + col) * 3 + 0] = a0; red[(ks * 64 + col) * 3 + 1] = a1; red[(ks * 64 + col) * 3 + 2] = a2;
            __syncthreads();
            if (tid < 192) { const int g = tid >> 6, c = tid & 63; float s = args.in[5][l * NMOD + c0 + c];
                for (int q = 0; q < 8; ++q) s += red[(q * 64 + c) * 3 + g];
                ((float*)(ws + WS_MODS))[(l * 3 + g) * NMOD + c0 + c] = s; }
            __syncthreads();
        }
        for (int i = gt; i < 4096; i += NTH) { const int pos = i >> 4, j = i & 15; const float inv = powf(10000.f, -(float)j / 16.f); const float ang = (float)pos * inv;
            ((float*)(ws + WS_ROPE))[2 * i] = (float)cos((double)ang); ((float*)(ws + WS_ROPE))[2 * i + 1] = (float)sin((double)ang); }
    }
    for (int i0 = gt; i0 < 8192; i0 += NTH) {
        const int li = i0 >> 12, i = i0 & 4095, dir = i >> 11, g = (i >> 6) & 31, p = i & 63;
        const double dt = exp((double)args.in[16][(li * 2 + dir) * 32 + g]);
        const double ar = args.in[14][((li * 2 + dir) * 32 + g) * 64 + p], ai = args.in[15][((li * 2 + dir) * 32 + g) * 64 + p];
        const double mag = exp(dt * ar), are = mag * cos(dt * ai), aim = mag * sin(dt * ai);
        const double den = ar * ar + ai * ai, xr = are - 1.0, xi = aim;
        const double cre = (xr * ar + xi * ai) / den, cim = (xi * ar - xr * ai) / den;
        double pr = are, pi = aim;
        for (int q = 0; q < 6; ++q) { const double nr = pr * pr - pi * pi, ni = 2.0 * pr * pi; pr = nr; pi = ni; }
        float* A = (float*)(ws + WS_S5A) + (size_t)i0 * 4; A[0] = (float)are; A[1] = (float)aim; A[2] = (float)pr; A[3] = (float)pi;
        bf16_t* B = (bf16_t*)(ws + WS_S5B) + ((size_t)((li * 2 + dir) * 32 + g) * 128 + 2 * p) * 16;
        const float* bre = args.in[17] + ((size_t)(li * 32 + g) * 64 + p) * 16; const float* bim = args.in[18] + ((size_t)(li * 32 + g) * 64 + p) * 16;
        for (int c = 0; c < 16; ++c) { const double br = bre[c], bi = bim[c]; B[c] = (bf16_t)f2bf((float)(cre * br - cim * bi)); B[16 + c] = (bf16_t)f2bf((float)(cre * bi + cim * br)); }
    }
    for (int i0 = gt; i0 < 65536; i0 += NTH) { const int li = i0 >> 15, i = i0 & 32767, g = i >> 10, c = (i >> 6) & 15, p = i & 63;
        bf16_t* C = (bf16_t*)(ws + WS_S5C) + (size_t)((li * 32 + g) * 16 + c) * 128 + 2 * p;
        C[0] = (bf16_t)f2bf(args.in[19][((size_t)(li * 32 + g) * 16 + c) * 64 + p]); C[1] = (bf16_t)f2bf(-args.in[20][((size_t)(li * 32 + g) * 16 + c) * 64 + p]); }
}
__device__ __forceinline__ void prep_phase(const AP& args, int li, LAS unsigned char* lds) {
    const int tid = otid(), lane = tid & 63, wave = tid >> 6, G = gridDim.x;
    unsigned char* ws = args.ws;
    LAS float* scr = (LAS float*)(lds + wave * 16384);
    const int gw = blockIdx.x * 8 + wave, NGW = G * 8;
    constexpr int I0 = 2816, I2 = 1408, I4 = 1536, I6 = 768, I7 = 512, I8 = 128;
    constexpr int NIT = 2 * I0 + 2 * I2 + 2 * I4 + I6 + I7 + I8;
    __syncthreads();
    for (int it = gw; it < NIT; it += NGW) {
        int r = it, mat, N, K; size_t woff;
        if (r < I0) { mat = 0; N = 5632; K = 1024; woff = W_GU; }
        else if ((r -= I0) < I0) { mat = 1; N = 5632; K = 1024; woff = W_GU + 5632ull * 1024 * 2; }
        else if ((r -= I0) < I2) { mat = 2; N = 1024; K = FFH; woff = W_DN; }
        else if ((r -= I2) < I2) { mat = 3; N = 1024; K = FFH; woff = W_DN + 1024ull * FFH * 2; }
        else if ((r -= I2) < I4) { mat = 4; N = 3072; K = 1024; woff = W_IN; }
        else if ((r -= I4) < I4) { mat = 5; N = 3072; K = 1024; woff = W_BG; }
        else if ((r -= I4) < I6) { mat = 6; N = 3072; K = 512; woff = W_PJ; }
        else if ((r -= I6) < I7) { mat = 7; N = 1024; K = 1024; woff = W_O3; }
        else { r -= I7; mat = 8; N = 512; K = 512; woff = W_GL; }
        bf16_t* WT = (bf16_t*)(ws + WS_W + woff);
        const int nblk = N / 32, kb = r / nblk, nb = r % nblk, k0 = 64 * kb, n0 = 32 * nb;
        size_t rs; const float* sp = wsrc_ptr(args, mat, li, k0 + (lane >> 5), n0 + (lane & 31), rs);
#pragma unroll 16
        for (int i = 0; i < 32; ++i) { const int kk = 2 * i + (lane >> 5); scr[kk * 33 + (lane & 31)] = sp ? sp[(size_t)(2 * i) * rs] : 0.f; }
        LDS_WAIT(); asm volatile("" ::: "memory");
        const int c = lane & 7;
#pragma unroll
        for (int j = 0; j < 4; ++j) { const int n = (lane >> 3) + 8 * j; const LAS float* s = scr + (8 * c) * 33 + n;
            u32x4 o; o.x = pk2(s[0 * 33], s[1 * 33]); o.y = pk2(s[2 * 33], s[3 * 33]); o.z = pk2(s[4 * 33], s[5 * 33]); o.w = pk2(s[6 * 33], s[7 * 33]);
            *(u32x4*)(WT + (size_t)(n0 + n) * K + k0 + 8 * c) = o; }
        LDS_WAIT(); asm volatile("" ::: "memory");
    }
}

__device__ __forceinline__ void norm_phase(const float* src_lat, const float* rd_ctx, float* cp_lat, float* src_ctx, const float* nw, const float* mods, int si, bf16_t* XN, const float* part, int npart) {
    const int tid_ = otid(), lane = tid_ & 63, gw = blockIdx.x * 8 + (tid_ >> 6), NGW = gridDim.x * 8;
    for (int r = gw; r < MT; r += NGW) {
        const float* xr = r < MLAT ? src_lat + (size_t)r * DM : rd_ctx + (size_t)(r - MLAT) * DM;
        const int grp = r < SEQL ? 0 : (r < MLAT ? 1 : 2);
        const float* sh = mods + grp * NMOD + si * DM; const float* sc = sh + DM;
        f32x4 v[4]; float s = 0.f;
#pragma unroll
        for (int j = 0; j < 4; ++j) v[j] = *(const f32x4*)(xr + 4 * (lane + 64 * j));
        if (r >= MLAT && npart > 0) {
            for (int q = 0; q < npart; ++q) { const float* pr = part + ((size_t)q * MCTX + (r - MLAT)) * DM;
#pragma unroll
                for (int j = 0; j < 4; ++j) v[j] += *(const f32x4*)(pr + 4 * (lane + 64 * j)); }
#pragma unroll
            for (int j = 0; j < 4; ++j) *(f32x4*)(src_ctx + (size_t)(r - MLAT) * DM + 4 * (lane + 64 * j)) = v[j];
        } else if (cp_lat) {
            float* cr = r < MLAT ? cp_lat + (size_t)r * DM : src_ctx + (size_t)(r - MLAT) * DM;
#pragma unroll
            for (int j = 0; j < 4; ++j) *(f32x4*)(cr + 4 * (lane + 64 * j)) = v[j];
        }
#pragma unroll
        for (int j = 0; j < 4; ++j) s += (v[j].x * v[j].x + v[j].y * v[j].y) + (v[j].z * v[j].z + v[j].w * v[j].w);
        const float rs = 1.0f / sqrtf(wave_sum(s) * (1.f / DM) + EPS);
#pragma unroll
        for (int j = 0; j < 4; ++j) { const int c = 4 * (lane + 64 * j);
            const f32x4 w = *(const f32x4*)(nw + c), a = *(const f32x4*)(sc + c), b = *(const f32x4*)(sh + c);
            const f32x4 y = (v[j] * rs * w) * (a + 1.0f) + b;
            u32x2 o; o.x = pk2(y.x, y.y); o.y = pk2(y.z, y.w);
            *(u32x2*)(XN + (size_t)r * DM + c) = o; }
    }
}

__device__ __forceinline__ void attn_prep(const AP& args, int li) {
    unsigned char* ws = args.ws;
    const bf16_t* Z = (const bf16_t*)(ws + WS_A);
    bf16_t* Qb = (bf16_t*)(ws + WS_QB); bf16_t* Kb = (bf16_t*)(ws + WS_KB); bf16_t* Vb = (bf16_t*)(ws + WS_VB);
    const float* rope = (const float*)(ws + WS_ROPE);
    const int tid_ = otid(), lane = tid_ & 63, gw = blockIdx.x * 8 + (tid_ >> 6), NGW = gridDim.x * 8;
    const int hq = lane >> 3, sub = lane & 7, ax = sub >> 2, j0 = 4 * (sub & 3), d1 = ax * 32 + j0;
    const f32x4 qw1 = *(const f32x4*)(args.in[24] + li * 64 + d1), qw2 = *(const f32x4*)(args.in[24] + li * 64 + d1 + 16);
    const f32x4 kw1 = *(const f32x4*)(args.in[25] + li * 64 + d1), kw2 = *(const f32x4*)(args.in[25] + li * 64 + d1 + 16);
    for (int r = gw; r < MT; r += NGW) {
        const bf16_t* zr = Z + (size_t)r * ZP;
        int b, kpos; f32x4 ra = (f32x4){1.f, 0.f, 1.f, 0.f}, rb = ra;
        if (r < MLAT) { b = r >> 14; const int t = r & (SEQL - 1); kpos = CTXL + t; const int pos = ax ? (t & 63) : (t >> 6);
            ra = *(const f32x4*)(rope + (pos * 16 + j0) * 2); rb = *(const f32x4*)(rope + (pos * 16 + j0) * 2 + 4); }
        else { b = (r - MLAT) >> 8; kpos = (r - MLAT) & 255; }
        const float cs[4] = {ra.x, ra.z, rb.x, rb.z}, sn[4] = {ra.y, ra.w, rb.y, rb.w};
#pragma unroll
        for (int pass = 0; pass < 2; ++pass) {
            const int hh = pass ? (8 + (hq & 1)) : hq;
            const u32x2 w1 = *(const u32x2*)(zr + hh * 64 + d1), w2 = *(const u32x2*)(zr + hh * 64 + d1 + 16);
            const float t1[4] = {bflo(w1.x), bfhi(w1.x), bflo(w1.y), bfhi(w1.y)}, t2[4] = {bflo(w2.x), bfhi(w2.x), bflo(w2.y), bfhi(w2.y)};
            float ss = 0.f;
#pragma unroll
            for (int i = 0; i < 4; ++i) ss += t1[i] * t1[i] + t2[i] * t2[i];
            ss += __shfl_xor(ss, 1); ss += __shfl_xor(ss, 2); ss += __shfl_xor(ss, 4);
            const float rs = (1.0f / sqrtf(ss * (1.f / 64.f) + EPS)) * (pass ? 1.f : attn_body::C2);
            const f32x4 wa = pass ? kw1 : qw1, wb = pass ? kw2 : qw2;
            float o1[4], o2[4];
#pragma unroll
            for (int i = 0; i < 4; ++i) { const float y1 = t1[i] * rs * wa[i], y2 = t2[i] * rs * wb[i]; o1[i] = y1 * cs[i] - y2 * sn[i]; o2[i] = y2 * cs[i] + y1 * sn[i]; }
            u32x2 p1, p2; p1.x = pk2(o1[0], o1[1]); p1.y = pk2(o1[2], o1[3]); p2.x = pk2(o2[0], o2[1]); p2.y = pk2(o2[2], o2[3]);
            if (pass == 0) { bf16_t* q = Qb + (size_t)r * 512 + hq * 64 + d1; *(u32x2*)q = p1; *(u32x2*)(q + 16) = p2; }
            else if (lane < 16) { bf16_t* k = Kb + ((size_t)b * KVL + kpos) * 128 + (hq & 1) * 64 + d1; *(u32x2*)k = p1; *(u32x2*)(k + 16) = p2; }
        }
        if (lane >= 16 && lane < 32) *(u32x4*)(Vb + ((size_t)b * KVL + kpos) * 128 + (lane - 16) * 8) = *(const u32x4*)(zr + ZV + (lane - 16) * 8);
    }
}

__device__ __forceinline__ bf16_t* gs_ptr(unsigned char* ws, size_t e) { return (bf16_t*)(ws + WS_Y) + (e >> 10) * 1536 + 512 + (e & 1023); }
__device__ __forceinline__ float logsig(float x) { return fminf(x, 0.f) - __logf(1.f + __expf(-fabsf(x))); }
#define GZI(t, j) ((t) * 32 + ((t) >> 4) * 8 + (j))
struct GlaGateW { float w[16]; float bias; };
__device__ __forceinline__ void gla_gate_weights(const AP& args, int li, int h, int tid, GlaGateW& W) {
    const int col = tid >> 2, dir = col >> 6, d = col & 63;
    const float* gw = args.in[11] + ((size_t)(li * 2 + dir) * 16) * 256 + h * 64 + d;
#pragma unroll
    for (int j = 0; j < 16; ++j) W.w[j] = gw[j * 256];
    W.bias = args.in[12][(li * 2 + dir) * 256 + h * 64 + d];
}
__device__ __forceinline__ void gla_gates(const GlaGateW& W, int tid, const LAS float* gz, LAS float* gcum) {
    const int q = tid & 3, col = tid >> 2, dir = col >> 6, dd = col & 63;
    float v[16];
#pragma unroll
    for (int i = 0; i < 16; ++i) { const int t = 16 * q + i; float x = W.bias;
#pragma unroll
        for (int j = 0; j < 16; ++j) x += gz[GZI(t, dir * 16 + j)] * W.w[j];
        v[i] = logsig(x) * (1.f / 16.f); }
    float tot;
    if (dir == 0) {
#pragma unroll
        for (int i = 1; i < 16; ++i) v[i] += v[i - 1];
        tot = v[15];
    } else {
#pragma unroll
        for (int i = 14; i >= 0; --i) v[i] += v[i + 1];
        tot = v[0];
    }
    const float u1 = __shfl_up(tot, 1), u2 = __shfl_up(tot, 2), u3 = __shfl_up(tot, 3), d1 = __shfl_down(tot, 1), d2 = __shfl_down(tot, 2), d3 = __shfl_down(tot, 3);
    const float off = (dir == 0) ? ((q >= 1 ? u1 : 0.f) + (q >= 2 ? u2 : 0.f) + (q >= 3 ? u3 : 0.f)) : ((q <= 2 ? d1 : 0.f) + (q <= 1 ? d2 : 0.f) + (q <= 0 ? d3 : 0.f));
    LAS float* gc = gcum + dir * 4096 + (16 * q) * 64 + dd;
#pragma unroll
    for (int i = 0; i < 16; ++i) gc[i * 64] = v[i] + off;
    __syncthreads();
}
__device__ __forceinline__ void gla_put_gz(const u32x2 w, int tid, LAS float* gz) {
    const int t = tid >> 3, j = (tid & 7) * 4;
    gz[GZI(t, j)] = bflo(w.x); gz[GZI(t, j + 1)] = bfhi(w.x); gz[GZI(t, j + 2)] = bflo(w.y); gz[GZI(t, j + 3)] = bfhi(w.y);
}
__device__ __forceinline__ void gla_put_vT(const u32x4 a, const u32x4 b, int tid, LAS bf16_t* dst, int ld) {
    const int t = tid >> 3, seg = tid & 7;
    const unsigned w[8] = {a.x, a.y, a.z, a.w, b.x, b.y, b.z, b.w};
#pragma unroll
    for (int i = 0; i < 8; ++i) { dst[(seg * 16 + 2 * i) * ld + t] = (bf16_t)(w[i] & 0xffffu); dst[(seg * 16 + 2 * i + 1) * ld + t] = (bf16_t)(w[i] >> 16); }
}
__device__ __forceinline__ void gla_state_phase(const AP& args, int li, LAS unsigned char* lds) {
    unsigned char* ws = args.ws; const bf16_t* Z = (const bf16_t*)(ws + WS_A); float* GD = (float*)(ws + WS_GD);
    const int tid = otid(), lane = tid & 63, wave = tid >> 6;
    LAS float* gz = (LAS float*)(lds + 77824); LAS float* gcum = (LAS float*)(lds + 8192);
    LAS bf16_t* koT = (LAS bf16_t*)(lds + 40960); LAS bf16_t* vT = (LAS bf16_t*)(lds + 59392);
    const int nslot = gridDim.x >> 3, h = blockIdx.x & 3, b = (blockIdx.x >> 2) & 1;
    if ((int)(blockIdx.x >> 3) >= nslot) return;
    GlaGateW GW; gla_gate_weights(args, li, h, tid, GW);
    for (int c = blockIdx.x >> 3; c < NCH; c += nslot) {
        const int r0 = chunk_row0(b, c);
        const u32x2 gzw = *(const u32x2*)(Z + (size_t)(r0 + (tid >> 3)) * ZP + GFB + (tid & 7) * 4);
        const bf16_t* vp_ = Z + (size_t)(r0 + (tid >> 3)) * ZP + GV + h * 128 + (tid & 7) * 16;
        const u32x4 va = *(const u32x4*)vp_, vb = *(const u32x4*)(vp_ + 8);
        const u32x4 kw = *(const u32x4*)(Z + (size_t)(r0 + (tid & 63)) * ZP + GK + h * 64 + (tid >> 6) * 8);
        gla_put_gz(gzw, tid, gz); gla_put_vT(va, vb, tid, vT, 72);
        __syncthreads();
        gla_gates(GW, tid, gz, gcum);
        { const int t = tid & 63, dg = tid >> 6;
          const float kv[8] = {bflo(kw.x), bfhi(kw.x), bflo(kw.y), bfhi(kw.y), bflo(kw.z), bfhi(kw.z), bflo(kw.w), bfhi(kw.w)};
#pragma unroll
          for (int dir = 0; dir < 2; ++dir)
#pragma unroll
              for (int i = 0; i < 8; ++i) { const int d = dg * 8 + i; const float tot = gcum[(dir * 64 + (dir ? 0 : 63)) * 64 + d];
                  koT[(dir * 64 + d) * 72 + t] = (bf16_t)f2bf(kv[i] * __expf(tot - gcum[(dir * 64 + t) * 64 + d])); }
          if (tid < 128) { const int dir = tid >> 6, d = tid & 63; GD[((size_t)((dir * 2 + b) * 4 + h) * NCH + c) * 64 + d] = __expf(gcum[(dir * 64 + (dir ? 0 : 63)) * 64 + d]); } }
        __syncthreads();
        for (int tt = wave; tt < 64; tt += 8) { const int dir = tt >> 5, it_ = (tt >> 3) & 3, jt = tt & 7;
            const f32x4 acc = mm_tile(koT + (dir * 64 + it_ * 16) * 72, 72, vT + (jt * 16) * 72, 72, 64, lane, (f32x4){0.f, 0.f, 0.f, 0.f});
            bf16_t* dst = gs_ptr(ws, ((size_t)((dir * 2 + b) * 4 + h) * NCH + c) * 8192 + (jt * 16 + (lane & 15)) * 64 + it_ * 16 + 4 * (lane >> 4));
            u32x2 o; o.x = pk2(acc[0], acc[1]); o.y = pk2(acc[2], acc[3]); *(u32x2*)dst = o; }
        __syncthreads();
    }
}
__device__ __forceinline__ void gla_out_phase(const AP& args, int li, LAS unsigned char* lds, int c0) {
    unsigned char* ws = args.ws; const bf16_t* Z = (const bf16_t*)(ws + WS_A); bf16_t* Y = (bf16_t*)(ws + WS_Y);
    const int tid = otid(), lane = tid & 63, wave = tid >> 6;
    LAS bf16_t* Acat = (LAS bf16_t*)lds;
    LAS bf16_t* Bcat = (LAS bf16_t*)(lds + 25600);
    LAS float* gz = (LAS float*)(lds + 136192);
    LAS float* gcum = (LAS float*)(lds + 84992);
    LAS bf16_t* kin = (LAS bf16_t*)(lds + 117760);
    LAS float* Of = (LAS float*)(lds + 84992);
    const int nslot = gridDim.x >> 3, h = blockIdx.x & 3, b = (blockIdx.x >> 2) & 1;
    if ((int)(blockIdx.x >> 3) >= nslot) return;
    GlaGateW GW; gla_gate_weights(args, li, h, tid, GW);
    for (int c = c0 + (blockIdx.x >> 3); c < NCH; c += nslot) {
        const int r0 = chunk_row0(b, c);
        const u32x2 gzw = *(const u32x2*)(Z + (size_t)(r0 + (tid >> 3)) * ZP + GFB + (tid & 7) * 4);
        const bf16_t* vp_ = Z + (size_t)(r0 + (tid >> 3)) * ZP + GV + h * 128 + (tid & 7) * 16;
        const u32x4 va = *(const u32x4*)vp_, vb = *(const u32x4*)(vp_ + 8);
        u32x4 gsv[4];
#pragma unroll
        for (int rep = 0; rep < 4; ++rep) { const int idx = tid + 512 * (rep & 1), dir = rep >> 1, dv = idx >> 3, seg = idx & 7;
            gsv[rep] = *(const u32x4*)gs_ptr(ws, ((size_t)((dir * 2 + b) * 4 + h) * NCH + c) * 8192 + dv * 64 + seg * 8); }
        const u32x4 qw = *(const u32x4*)(Z + (size_t)(r0 + (tid & 63)) * ZP + GQ + h * 64 + (tid >> 6) * 8), kw = *(const u32x4*)(Z + (size_t)(r0 + (tid & 63)) * ZP + GK + h * 64 + (tid >> 6) * 8);
        const bf16_t* rp_ = Z + (size_t)(r0 + (tid >> 3)) * ZP + GR + h * 128 + (tid & 7) * 16;
        const u32x4 ra = *(const u32x4*)rp_, rb = *(const u32x4*)(rp_ + 8);
        gla_put_gz(gzw, tid, gz); gla_put_vT(va, vb, tid, Bcat, 200);
#pragma unroll
        for (int rep = 0; rep < 4; ++rep) { const int idx = tid + 512 * (rep & 1), dir = rep >> 1, dv = idx >> 3, seg = idx & 7;
            *(LAS u32x4*)(Bcat + dv * 200 + 64 + dir * 64 + seg * 8) = gsv[rep]; }
        __syncthreads();
        gla_gates(GW, tid, gz, gcum);
        { const int t = tid & 63, dg = tid >> 6;
          const float qv[8] = {bflo(qw.x), bfhi(qw.x), bflo(qw.y), bfhi(qw.y), bflo(qw.z), bfhi(qw.z), bflo(qw.w), bfhi(qw.w)};
          const float kv[8] = {bflo(kw.x), bfhi(kw.x), bflo(kw.y), bfhi(kw.y), bflo(kw.z), bfhi(kw.z), bflo(kw.w), bfhi(kw.w)};
#pragma unroll
          for (int dir = 0; dir < 2; ++dir) { float qo[8], ko[8];
#pragma unroll
              for (int i = 0; i < 8; ++i) { const float bb = gcum[(dir * 64 + t) * 64 + dg * 8 + i]; qo[i] = qv[i] * __expf(bb) * 0.125f; ko[i] = kv[i] * __expf(-bb); }
              u32x4 o; o.x = pk2(qo[0], qo[1]); o.y = pk2(qo[2], qo[3]); o.z = pk2(qo[4], qo[5]); o.w = pk2(qo[6], qo[7]);
              *(LAS u32x4*)(Acat + t * 200 + 64 + dir * 64 + dg * 8) = o;
              o.x = pk2(ko[0], ko[1]); o.y = pk2(ko[2], ko[3]); o.z = pk2(ko[4], ko[5]); o.w = pk2(ko[6], ko[7]);
              *(LAS u32x4*)(kin + (dir * 64 + t) * 72 + dg * 8) = o; } }
        __syncthreads();
        for (int tt = wave; tt < 16; tt += 8) { const int it_ = tt >> 2, jt = tt & 3;
            const f32x4 af = mm_tile(kin + (it_ * 16) * 72, 72, Acat + (jt * 16) * 200 + 64, 200, 64, lane, (f32x4){0.f, 0.f, 0.f, 0.f});
            const f32x4 ab = mm_tile(kin + (64 + it_ * 16) * 72, 72, Acat + (jt * 16) * 200 + 128, 200, 64, lane, (f32x4){0.f, 0.f, 0.f, 0.f});
            const int i = jt * 16 + (lane & 15), j0 = it_ * 16 + 4 * (lane >> 4); float v[4];
#pragma unroll
            for (int q = 0; q < 4; ++q) { const int j = j0 + q; v[q] = (j <= i ? af[q] : 0.f) + (j >= i ? ab[q] : 0.f); }
            u32x2 o; o.x = pk2(v[0], v[1]); o.y = pk2(v[2], v[3]); *(LAS u32x2*)(Acat + i * 200 + j0) = o; }
        __syncthreads();
        for (int tt = wave; tt < 32; tt += 8) { const int it_ = tt >> 2, jt = tt & 3;
            const f32x4 acc = mm_tile(Bcat + (it_ * 16) * 200, 200, Acat + (jt * 16) * 200, 200, 192, lane, (f32x4){0.f, 0.f, 0.f, 0.f});
            *(LAS f32x4*)(Of + (jt * 16 + (lane & 15)) * 132 + it_ * 16 + 4 * (lane >> 4)) = acc; }
        __syncthreads();
        { const int t = tid >> 3, seg = tid & 7; float o[16]; float ss = 0.f;
#pragma unroll
          for (int q = 0; q < 4; ++q) { const f32x4 v = *(const LAS f32x4*)(Of + t * 132 + seg * 16 + 4 * q); o[4 * q] = v.x; o[4 * q + 1] = v.y; o[4 * q + 2] = v.z; o[4 * q + 3] = v.w; ss += (v.x * v.x + v.y * v.y) + (v.z * v.z + v.w * v.w); }
          ss += __shfl_xor(ss, 1); ss += __shfl_xor(ss, 2); ss += __shfl_xor(ss, 4);
          const float rs = 1.0f / sqrtf(ss * (1.f / 128.f) + EPS);
          const unsigned rw[8] = {ra.x, ra.y, ra.z, ra.w, rb.x, rb.y, rb.z, rb.w};
          const float* nw = args.in[13] + li * 128 + seg * 16;
          unsigned ow[8];
#pragma unroll
          for (int q = 0; q < 8; ++q) { const float y0 = o[2 * q] * rs * nw[2 * q] * siluf_(bflo(rw[q])), y1 = o[2 * q + 1] * rs * nw[2 * q + 1] * siluf_(bfhi(rw[q])); ow[q] = pk2(y0, y1); }
          bf16_t* yp = Y + (size_t)(r0 + t) * 1536 + h * 128 + seg * 16;
          *(u32x4*)yp = (u32x4){ow[0], ow[1], ow[2], ow[3]}; *(u32x4*)(yp + 8) = (u32x4){ow[4], ow[5], ow[6], ow[7]}; }
    }
    __syncthreads();
}

template <bool OUT> __device__ __forceinline__ void s5_phase(const AP& args, int li, LAS unsigned char* lds, int j0s) {
    unsigned char* ws = args.ws; const bf16_t* Z = (const bf16_t*)(ws + WS_A);
    const float* Atab = (const float*)(ws + WS_S5A) + (size_t)li * 16384; const bf16_t* Btab = (const bf16_t*)(ws + WS_S5B) + (size_t)li * 131072; const bf16_t* Ctab = (const bf16_t*)(ws + WS_S5C) + (size_t)li * 65536;
    f32x2* E = (f32x2*)(ws + WS_S5E); bf16_t* Y5 = (bf16_t*)(ws + WS_Y5);
    const int tid = otid(), lane = tid & 63, wave = tid >> 6;
    constexpr int LDB = 136, BUF = 64 * LDB;
    LAS bf16_t* buf = (LAS bf16_t*)lds;
    const int nslot = gridDim.x >> 3, gq = blockIdx.x & 7;
    if ((int)(blockIdx.x >> 3) >= nslot) return;
    const int ks = (lane >> 4) & 1; const bool kz = (lane >> 4) >= 2;
    const bf16x8 zero8 = (bf16x8){0, 0, 0, 0, 0, 0, 0, 0};
    const int gB = gq * 4 + (wave >> 1), dirB = wave & 1;
    bf16x8 xb[8];
#pragma unroll
    for (int it_ = 0; it_ < 8; ++it_) { xb[it_] = *(const bf16x8*)(Btab + ((size_t)(dirB * 32 + gB) * 128 + it_ * 16 + (lane & 15)) * 16 + 8 * ks); if (kz) xb[it_] = zero8; }
    const int p = tid & 63, dir_s = (tid >> 6) & 1, g_s = gq * 4 + (tid >> 7);
    const f32x4 A = *(const f32x4*)(Atab + (size_t)((dir_s * 32 + g_s) * 64 + p) * 4);
    bf16x8 xc[2][4]; f32x4 dd[2];
    if (OUT) {
#pragma unroll
        for (int k = 0; k < 2; ++k) { const int g = gq * 4 + (wave >> 2) + 2 * k;
#pragma unroll
            for (int kk = 0; kk < 4; ++kk) xc[k][kk] = *(const bf16x8*)(Ctab + (size_t)(g * 16 + (lane & 15)) * 128 + 8 * (lane >> 4) + 32 * kk);
            dd[k] = *(const f32x4*)(args.in[21] + li * 512 + g * 16 + 4 * (lane >> 4)); }
    }
#define S5_LOAD(J, YB, H0R, H0I, UW) do { const int b_ = (J) & 1, c_ = (J) >> 1, r0_ = chunk_row0(b_, c_); \
        _Pragma("unroll") for (int jt = 0; jt < 4; ++jt) { YB[jt] = *(const bf16x8*)(Z + (size_t)(r0_ + jt * 16 + (lane & 15)) * ZP + SU + gB * 16 + 8 * ks); if (kz) YB[jt] = zero8; } \
        if (OUT) { const f32x2 h0_ = E[((size_t)((dir_s * 2 + b_) * 32 + g_s) * NCH + c_) * 64 + p]; H0R = h0_.x; H0I = h0_.y; \
            _Pragma("unroll") for (int k = 0; k < 2; ++k) UW[k] = *(const u32x2*)(Z + (size_t)(r0_ + (wave & 3) * 16 + (lane & 15)) * ZP + SU + (gq * 4 + (wave >> 2) + 2 * k) * 16 + 4 * (lane >> 4)); } } while (0)
    bf16x8 yb[4], ybn[4]; float h0r = 0.f, h0i = 0.f, hnr = 0.f, hni = 0.f; u32x2 uw[2], uwn[2];
    uw[0] = uw[1] = uwn[0] = uwn[1] = (u32x2){0u, 0u};
#pragma unroll
    for (int jt = 0; jt < 4; ++jt) ybn[jt] = zero8;
    { const int j0 = j0s + (blockIdx.x >> 3); if (j0 < NCH * 2) S5_LOAD(j0, yb, h0r, h0i, uw); }
    for (int j = j0s + (blockIdx.x >> 3); j < NCH * 2; j += nslot) {
        const int b = j & 1, c = j >> 1, r0 = chunk_row0(b, c);
        const size_t eidx = ((size_t)((dir_s * 2 + b) * 32 + g_s) * NCH + c) * 64 + p;
#pragma unroll
        for (int jt = 0; jt < 4; ++jt)
#pragma unroll
            for (int it_ = 0; it_ < 8; ++it_) {
                const f32x4 acc = __builtin_amdgcn_mfma_f32_16x16x32_bf16(xb[it_], yb[jt], (f32x4){0.f, 0.f, 0.f, 0.f}, 0, 0, 0);
                u32x2 o; o.x = pk2(acc[0], acc[1]); o.y = pk2(acc[2], acc[3]);
                *(LAS u32x2*)(buf + wave * BUF + (jt * 16 + (lane & 15)) * LDB + it_ * 16 + 4 * (lane >> 4)) = o; }
        if (j + nslot < NCH * 2) S5_LOAD(j + nslot, ybn, hnr, hni, uwn);
        asm volatile("s_waitcnt lgkmcnt(0)" ::: "memory");
        float hr = h0r, hi = h0i;
        { LAS unsigned* bp = (LAS unsigned*)(buf + wave * BUF + 2 * p);
          for (int s0 = 0; s0 < 64; s0 += 8) { unsigned w[8], o[8];
#pragma unroll
              for (int q = 0; q < 8; ++q) { const int t = dir_s ? 63 - (s0 + q) : s0 + q; w[q] = bp[t * (LDB / 2)]; }
#pragma unroll
              for (int q = 0; q < 8; ++q) { const float nr = A.x * hr - A.y * hi + bflo(w[q]), ni = A.x * hi + A.y * hr + bfhi(w[q]); hr = nr; hi = ni; o[q] = pk2(hr, hi); }
              if (OUT) {
#pragma unroll
                  for (int q = 0; q < 8; ++q) { const int t = dir_s ? 63 - (s0 + q) : s0 + q; bp[t * (LDB / 2)] = o[q]; } } }
          if (!OUT) E[eidx] = (f32x2){hr, hi}; }
        if (OUT) __syncthreads(); else asm volatile("s_waitcnt lgkmcnt(0)" ::: "memory");
        if (OUT) {
#pragma unroll
            for (int k = 0; k < 2; ++k) { const int gi = (wave >> 2) + 2 * k, jt = wave & 3, g = gq * 4 + gi;
                f32x4 acc = (f32x4){0.f, 0.f, 0.f, 0.f};
#pragma unroll
                for (int dir = 0; dir < 2; ++dir) { const LAS bf16_t* yp = buf + (gi * 2 + dir) * BUF + (jt * 16 + (lane & 15)) * LDB + 8 * (lane >> 4);
#pragma unroll
                    for (int kk = 0; kk < 4; ++kk) acc = __builtin_amdgcn_mfma_f32_16x16x32_bf16(xc[k][kk], *(const LAS bf16x8*)(yp + 32 * kk), acc, 0, 0, 0); }
                const int t = jt * 16 + (lane & 15), c4 = 4 * (lane >> 4);
                const float y0 = gelu_tanh(acc[0] + dd[k].x * bflo(uw[k].x)), y1 = gelu_tanh(acc[1] + dd[k].y * bfhi(uw[k].x)), y2 = gelu_tanh(acc[2] + dd[k].z * bflo(uw[k].y)), y3 = gelu_tanh(acc[3] + dd[k].w * bfhi(uw[k].y));
                u32x2 o; o.x = pk2(y0, y1); o.y = pk2(y2, y3);
                *(u32x2*)(Y5 + (size_t)(r0 + t) * 512 + g * 16 + c4) = o; }
            __syncthreads();
        }
#pragma unroll
        for (int jt = 0; jt < 4; ++jt) yb[jt] = ybn[jt];
        h0r = hnr; h0i = hni; uw[0] = uwn[0]; uw[1] = uwn[1];
    }
#undef S5_LOAD
}

__device__ __forceinline__ void scan_phase(const AP& args, int li) {
    unsigned char* ws = args.ws; const float* GD = (const float*)(ws + WS_GD);
    f32x2* E = (f32x2*)(ws + WS_S5E); const float* Atab = (const float*)(ws + WS_S5A) + (size_t)li * 16384;
    const int gt = blockIdx.x * 512 + otid(), NTH = gridDim.x * 512;
    constexpr int NB = 10;
    for (int e = gt; e < 16 * 8192; e += NTH) {
        const int combo = e >> 13, el = e & 8191, dk = el & 63, dir = combo >> 3;
        const size_t ebase0 = (size_t)combo * NCH * 8192 + el; const float* dbase = GD + (size_t)combo * NCH * 64 + dk;
        const bool s5 = e < 8192;
        const int p = e & 63, g = (e >> 6) & 31, b5 = (e >> 11) & 1, dir5 = (e >> 12) & 1;
        const f32x4 A = s5 ? *(const f32x4*)(Atab + (size_t)((dir5 * 32 + g) * 64 + p) * 4) : (f32x4){0.f, 0.f, 0.f, 0.f};
        f32x2* ebase = E + ((size_t)((dir5 * 2 + b5) * 32 + g) * NCH) * 64 + p;
        float S = 0.f, hr = 0.f, hi = 0.f;
        float d0[NB], c0[NB], d1[NB], c1[NB]; f32x2 v0[NB], v1[NB];
#define SC_LOAD(D, C, V, S0) do { _Pragma("unroll") for (int q = 0; q < NB; ++q) { const int cc_ = chunk_of((S0) + q, dir); D[q] = bf2f(*gs_ptr(ws, ebase0 + (size_t)cc_ * 8192)); C[q] = dbase[cc_ * 64]; } \
        if (s5) { _Pragma("unroll") for (int q = 0; q < NB; ++q) V[q] = ebase[chunk_of((S0) + q, dir5) * 64]; } } while (0)
#define SC_RUN(D, C, V, S0) do { _Pragma("unroll") for (int q = 0; q < NB; ++q) { const int cc_ = chunk_of((S0) + q, dir); *gs_ptr(ws, ebase0 + (size_t)cc_ * 8192) = (bf16_t)f2bf(S); S = C[q] * S + D[q]; } \
        if (s5) { _Pragma("unroll") for (int q = 0; q < NB; ++q) { ebase[chunk_of((S0) + q, dir5) * 64] = (f32x2){hr, hi}; const float nr = A.z * hr - A.w * hi + V[q].x, ni = A.z * hi + A.w * hr + V[q].y; hr = nr; hi = ni; } } } while (0)
        SC_LOAD(d0, c0, v0, 0);
        for (int s = 0; s < NCH; s += 2 * NB) {
            SC_LOAD(d1, c1, v1, s + NB);
            SC_RUN(d0, c0, v0, s);
            if (s + 2 * NB < NCH) SC_LOAD(d0, c0, v0, s + 2 * NB);
            SC_RUN(d1, c1, v1, s + NB);
        }
#undef SC_LOAD
#undef SC_RUN
    }
}

__device__ __forceinline__ void final_phase(const AP& args) {
    const int tid_ = otid(), lane = tid_ & 63, gw = blockIdx.x * 8 + (tid_ >> 6), NGW = gridDim.x * 8;
    const float* nw = args.in[30];
    for (int r = gw; r < MLAT; r += NGW) {
        float* xr = args.out + (size_t)r * DM;
        f32x4 v[4]; float s = 0.f;
#pragma unroll
        for (int j = 0; j < 4; ++j) { v[j] = *(const f32x4*)(xr + 4 * (lane + 64 * j)); s += (v[j].x * v[j].x + v[j].y * v[j].y) + (v[j].z * v[j].z + v[j].w * v[j].w); }
        const float rs = 1.0f / sqrtf(wave_sum(s) * (1.f / DM) + EPS);
#pragma unroll
        for (int j = 0; j < 4; ++j) { const int c = 4 * (lane + 64 * j); *(f32x4*)(xr + c) = v[j] * rs * *(const f32x4*)(nw + c); }
    }
}

constexpr size_t WS_BAR = 3584 * 1024;
#define XB_TMO      128
#define XB_XCNT(j)  (256  + 64 * (j))
#define XB_XSUB(j)  (1280 + 64 * (j))
#define XB_XGEN(j)  (2304 + 64 * (j))
#define XB_TOP      3328
#define XB_TOPGEN   3392
#define XCD_BAR_WORDS 3456
#define XB_SPIN_CAP (1u << 18)
__device__ __forceinline__ unsigned xb_ld(unsigned* p)              { return __hip_atomic_load(p, __ATOMIC_RELAXED, __HIP_MEMORY_SCOPE_AGENT); }
__device__ __forceinline__ unsigned xb_add(unsigned* p, unsigned v) { return __hip_atomic_fetch_add(p, v, __ATOMIC_RELAXED, __HIP_MEMORY_SCOPE_AGENT); }
__device__ __forceinline__ unsigned xb_xcc_id() { return (unsigned)__builtin_amdgcn_s_getreg((3 << 11) | 20) & 0xFu; }
#define XB_SPIN(cond, bar) do { unsigned _sp = 0; while (cond) { __builtin_amdgcn_s_sleep(1); \
    if ((++_sp & 255u) == 0u) { if (xb_ld(&(bar)[XB_TMO])) break; if (_sp > XB_SPIN_CAP) { atomicAdd(&(bar)[XB_TMO], 1u); break; } } } } while (0)
__shared__ unsigned xb_st[4];
struct XcdBarrier { unsigned* bar; unsigned x; };
__device__ __forceinline__ XcdBarrier xcd_barrier_post(unsigned* bar) {
    XcdBarrier b; b.bar = bar; b.x = xb_xcc_id();
    if (threadIdx.x == 0) (void)xb_add(&bar[XB_XCNT(b.x)], 1u);
    return b;
}
__device__ __forceinline__ void xcd_barrier_complete(unsigned* bar, unsigned x, unsigned& nloc, unsigned& nx) {
    const unsigned G = gridDim.x * gridDim.y * gridDim.z;
    unsigned sum, cnt, mine, sp = 0u;
    for (;;) {
        sum = 0u; cnt = 0u; mine = 0u;
#pragma unroll
        for (unsigned j = 0; j < 16; ++j) { const unsigned c = xb_ld(&bar[XB_XCNT(j)]); sum += c; cnt += (c > 0u) ? 1u : 0u; mine = (j == x) ? c : mine; }
        if (sum == G) break;
        __builtin_amdgcn_s_sleep(1);
        if ((++sp & 255u) == 0u) { if (xb_ld(&bar[XB_TMO])) break; if (sp > XB_SPIN_CAP) { atomicAdd(&bar[XB_TMO], 1u); break; } }
    }
    nloc = mine > 0u ? mine : 1u; nx = cnt > 0u ? cnt : 1u;
}
__device__ __forceinline__ void xcd_barrier(const XcdBarrier& b) {
    asm volatile("s_waitcnt vmcnt(0)" ::: "memory");
    __syncthreads();
    if (threadIdx.x == 0) {
        unsigned* bar = b.bar;
        __builtin_amdgcn_s_waitcnt(0);
        volatile unsigned* st = xb_st;
        unsigned nloc = st[0], nx = st[1];
        if (nloc == 0u) { xcd_barrier_complete(bar, b.x, nloc, nx); st[0] = nloc; st[1] = nx; }
        const unsigned old = xb_add(&bar[XB_XSUB(b.x)], 1u);
        const unsigned gen = old / nloc;
        if (old + 1u == (gen + 1u) * nloc) {
            __builtin_amdgcn_fence(__ATOMIC_RELEASE, "agent");
            asm volatile("s_waitcnt vmcnt(0)" ::: "memory");
            const unsigned og = xb_add(&bar[XB_TOP], 1u);
            const unsigned tg = og / nx;
            if (og + 1u == (tg + 1u) * nx) xb_add(&bar[XB_TOPGEN], 1u);
            else XB_SPIN(xb_ld(&bar[XB_TOPGEN]) == tg, bar);
            __builtin_amdgcn_fence(__ATOMIC_ACQUIRE, "agent");
            xb_add(&bar[XB_XGEN(b.x)], 1u);
            asm volatile("s_waitcnt vmcnt(0)" ::: "memory");
        } else {
            XB_SPIN(xb_ld(&bar[XB_XGEN(b.x)]) == gen, bar);
            __builtin_amdgcn_fence(__ATOMIC_ACQUIRE, "agent");
            asm volatile("s_waitcnt vmcnt(0)" ::: "memory");
        }
    }
    __syncthreads();
}
#ifndef MAXPC
#define MAXPC 32
#endif
#ifndef PROBE_MASK
#define PROBE_MASK 0
#endif
#define PROBEB(bit, ...) do { if (PROBE_MASK & (bit)) { __VA_ARGS__ } } while (0)
template <int LI> __device__ __forceinline__ void run_layer(const AP& args0, LAS unsigned char* lds, unsigned char* lds_raw, const XcdBarrier& xbar, int lim) {
    constexpr int li = LI;
    const int G = gridDim.x;
#pragma unroll 1
    for (int s = 0; s < 16 && (LI * 16 + s) < lim; ++s) {
        AP args = args0; { unsigned char* w_ = args0.ws; float* o_ = args0.out; asm volatile("" : "+s"(w_), "+s"(o_)); args.ws = w_; args.out = o_; }
        unsigned char* ws = args.ws;
        float* hctx = (float*)(ws + WS_HCTX);
        bf16_t* XN = (bf16_t*)(ws + WS_XN);
        bf16_t* AB = (bf16_t*)(ws + WS_A);
        bf16_t* Y = (bf16_t*)(ws + WS_Y);
        const float* mods = (const float*)(ws + WS_MODS) + (size_t)li * 3 * NMOD;
        const float* hl = args.out; const float* hc = hctx;
        if (s == 1) continue;
        if (s == 0 && LI > 0) { prep_phase(args, li, lds); __syncthreads(); }
        if (s == 0 || s == 4 || s == 13) {
            const int a = (s == 0) ? 0 : (s == 13 ? 2 : 1);
            const int npart = (s == 13) ? (LI == 0 ? 8 : 0) : ((s == 4 || (s == 0 && LI > 0)) ? 22 : 0);
            const bool inp = (LI == 0 && s == 0);
            norm_phase(inp ? args.in[0] : hl, inp ? args.in[2] : (const float*)hctx, inp ? args.out : (float*)nullptr, hctx, args.in[6] + (li * 3 + a) * DM, mods, a * 3, XN, (const float*)(ws + WS_Y), npart);
        }
        if (s == 6) { attn_prep(args, li); gla_state_phase(args, li, lds); s5_phase<false>(args, li, lds, 0); PROBEB(4, attn_prep(args, li);); PROBEB(8, gla_state_phase(args, li, lds);); PROBEB(16, s5_phase<false>(args, li, lds, 0);); }
        if (s == 7) scan_phase(args, li);
        if (s == 8) {
            gla_out_phase(args, li, lds, LI == 1 ? 4 : 0);
            s5_phase<true>(args, li, lds, LI == 1 ? 8 : 0);
            xcd_barrier(xbar);
            const attn_body::bf16* Qb = (const attn_body::bf16*)(ws + WS_QB); const attn_body::bf16* Kb = (const attn_body::bf16*)(ws + WS_KB); const attn_body::bf16* Vb = (const attn_body::bf16*)(ws + WS_VB);
            attn_body::bf16* Yo = (attn_body::bf16*)(ws + WS_Y);
            for (int u = blockIdx.x; u < 1024; u += G) { const int b = u >> 9, qb = (u >> 3) & 63, h = u & 7; const size_t qrow = (size_t)b * SEQL + qb * 256;
                attn_body::attn_unit<8>(Qb + qrow * 512 + h * 64, Kb + (size_t)b * KVL * 128 + (h >> 2) * 64, Vb + (size_t)b * KVL * 128 + (h >> 2) * 64, Yo + qrow * 1536 + 1024 + h * 64, KVL / 64, (char*)lds_raw); }
            if (LI == 0) for (int u = blockIdx.x; u < 16; u += G) { const int b = u >> 3, h = u & 7; const size_t qrow = (size_t)MLAT + b * CTXL;
                attn_body::attn_unit<8>(Qb + qrow * 512 + h * 64, Kb + (size_t)b * KVL * 128 + (h >> 2) * 64, Vb + (size_t)b * KVL * 128 + (h >> 2) * 64, Yo + qrow * 1536 + 1024 + h * 64, CTXL / 64, (char*)lds_raw); }
        }
        const bool is_gemm = (s == 2 || s == 3 || s == 5 || (s >= 9 && s <= 12) || s == 14 || s == 15);
        if (is_gemm) {
            __syncthreads();
            const bf16_t* Wb = (const bf16_t*)(ws + WS_W);
            pg8::StaticOrder S;
            constexpr int MPOST = (LI == 1) ? MLAT : MT;
            if (s == 2 || s == 14) { const int f = (s == 14);
                S.init(f ? MPOST : MT, 5632, G, (int)blockIdx.x, 16);
                for (int rep_ = 0; rep_ < ((PROBE_MASK & 256) ? 2 : 1); ++rep_) { if (rep_) __syncthreads();
                pg8::gemm_phase<pg8::EpiSwiglu, pg8::StaticOrder, 1024, 1024, 1024, 30, 0>(lds, pg8::Gemm{XN, Wb + (W_GU / 2) + (size_t)f * 5632 * 1024}, S, pg8::EpiSwiglu{AB}); } }
            else if (s == 3 || s == 15) { const int f = (s == 15);
                pg8::SplitOrder SS; SS.init(G, (int)blockIdx.x, FFH / 64, !(LI == 1 && f));
                if (PROBE_MASK & 1024) { pg8::gemm_phase<pg8::EpiResid, pg8::SplitOrder, FFH, FFH, FFH, 30, 0>(lds, pg8::Gemm{AB, Wb + (W_DN / 2) + (size_t)f * 1024 * FFH}, SS, pg8::EpiResid{args.out, (float*)(ws + WS_Y), mods + (f ? 8 : 2) * DM, 0.0f}); __syncthreads(); }
                pg8::gemm_phase<pg8::EpiResid, pg8::SplitOrder, FFH, FFH, FFH, 30, 0>(lds, pg8::Gemm{AB, Wb + (W_DN / 2) + (size_t)f * 1024 * FFH}, SS, pg8::EpiResid{args.out, (float*)(ws + WS_Y), mods + (f ? 8 : 2) * DM, 0.5f}); }
            else if (s == 5) { S.init(MT, 3072, G, (int)blockIdx.x, 16);
                pg8::gemm_phase<pg8::EpiBf<0, ZP, ZP>, pg8::StaticOrder, 1024, 1024, 1024, 30, 0>(lds, pg8::Gemm{XN, Wb + (W_IN / 2)}, S, pg8::EpiBf<0, ZP, ZP>{AB, nullptr, nullptr}); }
            else if (s == 9) { S.init(MPOST, 512, G, (int)blockIdx.x, 8);
                pg8::gemm_phase<pg8::EpiBf<3, 1536, 512>, pg8::StaticOrder, 512, 512, 512, 30, 0>(lds, pg8::Gemm{(const bf16_t*)(ws + WS_Y5), Wb + (W_GL / 2)}, S, pg8::EpiBf<3, 1536, 512>{Y + 512, (const bf16_t*)(ws + WS_Y5), args.in[23] + li * 512}); }
            else if (s == 10) { S.init(MPOST, 3072, G, (int)blockIdx.x, 16);
                pg8::gemm_phase<pg8::EpiBf<5, 3072, 3072>, pg8::StaticOrder, 1024, 1024, 1024, 30, 0>(lds, pg8::Gemm{XN, Wb + (W_BG / 2)}, S, pg8::EpiBf<5, 3072, 3072>{AB, nullptr, args.in[27] + li * 3072}); }
            else if (s == 11) { pg8::BranchOrder BO; BO.init(MPOST, G, (int)blockIdx.x, 8);
                pg8::gemm_phase<pg8::EpiBranch, pg8::BranchOrder, 512, 1536, 512, 2, 512>(lds, pg8::Gemm{Y, Wb + (W_PJ / 2)}, BO, pg8::EpiBranch{AB, XN}); }
            else { pg8::SplitOrder SS; SS.init(G, (int)blockIdx.x, 1024 / 64, LI == 0);
                pg8::gemm_phase<pg8::EpiResid, pg8::SplitOrder, 1024, 1024, 1024, 30, 0>(lds, pg8::Gemm{XN, Wb + (W_O3 / 2)}, SS, pg8::EpiResid{args.out, (float*)(ws + WS_Y), mods + 5 * DM, 1.f}); }
        }
        xcd_barrier(xbar);
    }
}
__global__ void __launch_bounds__(512, 2) fwd_megakernel(Args kargs) {
    extern __shared__ __attribute__((aligned(16))) unsigned char lds_raw[];
    LAS unsigned char* lds = (LAS unsigned char*)lds_raw;
    cg::grid_group grid = cg::this_grid();
    const AP& args = kargs;
    if (threadIdx.x < 4) xb_st[threadIdx.x] = 0u;
    if (blockIdx.x == 0) {
        unsigned* bw = (unsigned*)(kargs.ws + WS_BAR);
        for (int i = threadIdx.x; i < XCD_BAR_WORDS; i += 512) __hip_atomic_store(bw + i, 0u, __ATOMIC_RELAXED, __HIP_MEMORY_SCOPE_AGENT);
    }
    __syncthreads();
    tables_phase(args, lds);
    __syncthreads();
    prep_phase(args, 0, lds);
    grid.sync();
    const XcdBarrier xbar = xcd_barrier_post((unsigned*)(kargs.ws + WS_BAR));
    int lim = MAXPC; asm volatile("" : "+s"(lim));
    run_layer<0>(args, lds, lds_raw, xbar, lim);
    run_layer<1>(args, lds, lds_raw, xbar, lim);
    final_phase(args);
}

extern "C" void kernel_launch(void* const* d_in, const int* in_sizes, int n_in, void* d_out, int out_size, void* d_ws, size_t ws_size, hipStream_t stream) {
    static int grid = 0;
    if (grid == 0) {
        int dev = 0, cus = 0, per_cu = 0;
        (void)hipGetDevice(&dev);
        (void)hipDeviceGetAttribute(&cus, hipDeviceAttributeMultiprocessorCount, dev);
        if (hipFuncSetAttribute((const void*)fwd_megakernel, hipFuncAttributeMaxDynamicSharedMemorySize, LDS_BYTES) != hipSuccess) fprintf(stderr, "kernel_launch: hipFuncSetAttribute failed\n");
        if (hipOccupancyMaxActiveBlocksPerMultiprocessor(&per_cu, (const void*)fwd_megakernel, 512, LDS_BYTES) != hipSuccess || per_cu < 1) { fprintf(stderr, "kernel_launch: occupancy query says %d\n", per_cu); per_cu = 1; }
        (void)hipGetLastError();
        if (cus <= 0) cus = 256;
        grid = cus * 1;
        if (ws_size < WS_END || n_in != 31) fprintf(stderr, "kernel_launch: ws %zu (need %zu), n_in %d\n", ws_size, (size_t)WS_END, n_in);
    }
    if (ws_size < WS_END) return;
    { static const int exp_sz[31] = {33554432, 2048, 524288, 1024, 18874368, 18432, 6144, 11534336, 11534336, 11534336, 5832704, 16384, 1024, 256, 8192, 8192, 128, 65536, 65536, 65536, 65536, 1024, 524288, 1024, 128, 128, 6291456, 6144, 3145728, 2097152, 1024};
      if (n_in != 31 || out_size != 33554432) return;
      for (int i = 0; i < 31; ++i) if (in_sizes[i] != exp_sz[i]) { fprintf(stderr, "kernel_launch: input %d has %d elements, expected %d\n", i, in_sizes[i], exp_sz[i]); return; } }
    Args a{};
    for (int i = 0; i < 31; ++i) a.in[i] = (const float*)d_in[i];
    a.out = (float*)d_out; a.ws = (unsigned char*)d_ws;
    void* kargs[] = {&a};
    hipError_t e = hipLaunchCooperativeKernel((const void*)fwd_megakernel, dim3(grid), dim3(512), kargs, LDS_BYTES, stream);
    if (e != hipSuccess) fprintf(stderr, "cooperative launch failed: %s (grid %d)\n", hipGetErrorString(e), grid);
}
```

```cpp
#include <hip/hip_runtime.h>
#include <hip/hip_cooperative_groups.h>
#include <hip/hip_bf16.h>
#include <cstdio>
#include <cstdint>
#include <cmath>
namespace cg = cooperative_groups;

#define LAS __attribute__((address_space(3)))
typedef unsigned short bf16_t;
typedef short bf16x8 __attribute__((ext_vector_type(8)));
typedef float f32x4 __attribute__((ext_vector_type(4)));
typedef float f32x2 __attribute__((ext_vector_type(2)));
typedef unsigned u32x4 __attribute__((ext_vector_type(4)));
typedef unsigned u32x2 __attribute__((ext_vector_type(2)));

constexpr int DM = 1024, MLAT = 32768, MCTX = 512, MT = 33280, SEQL = 16384, CTXL = 256, KVL = 16640;
constexpr int FFH = 2816, ZP = 2848, NCH = 260, NMOD = 9216;
constexpr float EPS = 1e-6f;
constexpr int ZQ = 0, ZK = 512, ZV = 640, GQ = 768, GK = 1024, GV = 1280, GR = 1792, SU = 2304, GFB = 2816;
constexpr size_t MiB = 1u << 20;
constexpr size_t WS_MODS = 0;
constexpr size_t WS_ROPE = 256 * 1024;
constexpr size_t WS_S5A = 320 * 1024;
constexpr size_t WS_S5B = 448 * 1024;
constexpr size_t WS_S5C = 960 * 1024;
constexpr size_t WS_GD = 2 * MiB;
constexpr size_t WS_HCTX = 4 * MiB;
constexpr size_t WS_W = 8 * MiB;
constexpr size_t W_GU = 0, W_DN = W_GU + 2ull * 5632 * 1024 * 2, W_IN = W_DN + 2ull * 1024 * 2816 * 2, W_BG = W_IN + 3072ull * 1024 * 2,
                 W_PJ = W_BG + 3072ull * 1024 * 2, W_O3 = W_PJ + 3072ull * 512 * 2, W_GL = W_O3 + 1024ull * 3072 * 2, W_END = W_GL + 512ull * 512 * 2;
static_assert(W_END <= 55 * MiB, "weights");
constexpr size_t WS_XN = 63 * MiB;
constexpr size_t WS_A = 128 * MiB;
constexpr size_t WS_QB = 309 * MiB;
constexpr size_t WS_KB = WS_QB + (size_t)MT * 512 * 2;
constexpr size_t WS_VB = WS_KB + 2ull * KVL * 128 * 2;
constexpr size_t WS_Y = WS_VB + 2ull * KVL * 128 * 2;
constexpr size_t WS_Y5 = WS_Y + (size_t)MT * 1536 * 2;
constexpr size_t WS_S5E = WS_Y5 + (size_t)MT * 512 * 2;
constexpr size_t WS_END = WS_S5E + 2ull * 2 * 32 * 260 * 64 * 8;
static_assert(WS_A + (size_t)MT * ZP * 2 <= WS_QB && WS_A + (size_t)MT * 3072 * 2 <= WS_KB && WS_END <= 505 * MiB, "ws map");
constexpr int LDS_BYTES = 147456;

struct Args { const float* in[31]; float* out; unsigned char* ws; };
typedef Args AP;

typedef __bf16 hwbf16x2 __attribute__((ext_vector_type(2)));
__device__ __forceinline__ unsigned pk2(float lo, float hi) { const f32x2 v = {lo, hi}; return __builtin_bit_cast(unsigned, __builtin_convertvector(v, hwbf16x2)); }
__device__ __forceinline__ unsigned f2bf(float f) { return pk2(f, 0.f) & 0xffffu; }
__device__ __forceinline__ float bflo(unsigned w) { return __builtin_bit_cast(float, w << 16); }
__device__ __forceinline__ float bfhi(unsigned w) { return __builtin_bit_cast(float, w & 0xffff0000u); }
__device__ __forceinline__ float bf2f(bf16_t h) { return __builtin_bit_cast(float, ((unsigned)h) << 16); }
__device__ __forceinline__ float wave_sum(float v) {
#pragma unroll
    for (int o = 1; o < 64; o <<= 1) v += __shfl_xor(v, o);
    return v;
}
__device__ __forceinline__ float sigmoidf_(float x) { return __builtin_amdgcn_rcpf(1.f + __expf(-x)); }
__device__ __forceinline__ float siluf_(float x) { return x * sigmoidf_(x); }
__device__ __forceinline__ float gelu_tanh(float x) { const float z = 0.7978845608028654f * (x + 0.044715f * x * x * x); const float t = 1.f - 2.f * __builtin_amdgcn_rcpf(__expf(2.f * z) + 1.f); return 0.5f * x * (1.f + t); }
__device__ __forceinline__ int chunk_row0(int b, int c) { return c < 4 ? MLAT + b * CTXL + 64 * c : b * SEQL + 64 * (c - 4); }
__device__ __forceinline__ int chunk_of(int s, int dir) { return dir == 0 ? s : (s < 4 ? 3 - s : 263 - s); }
#define LDS_WAIT() asm volatile("s_waitcnt lgkmcnt(0)" ::: "memory")
__device__ __forceinline__ int otid() { int t = threadIdx.x; asm volatile("" : "+v"(t)); return t; }

namespace pg8 {
constexpr int BM = 256, BK = 64, HALF = 128, HTB = HALF * BK * 2, STAGE_BYTES = 8 * HTB, NXCD = 8, WGM = 8;
__host__ __device__ __forceinline__ int lds_byte(int r, int c) { const int st = (r >> 4) * 2 + (c >> 5), rr = r & 15, cc = c & 31, ob = rr * 64 + cc * 2; return st * 1024 + (ob ^ (((ob >> 9) & 1) << 5)); }
__host__ __device__ __forceinline__ void stage_rc(int b, int& R, int& C) { const int st = b / 1024, sb = b % 1024, swz = sb ^ (((sb >> 9) & 1) << 5); R = (st >> 1) * 16 + swz / 64; C = (st & 1) * 32 + (swz % 64) / 2; }
__host__ __device__ __forceinline__ int perm32(int rho) { const int n = rho >> 4, i = rho & 15; return 8 * (i >> 2) + 4 * n + (i & 3); }
struct Unit { int pm, pn, kt0, nkt; };
struct Gemm { const bf16_t* A; const bf16_t* Bt; };
struct StaticOrder {
    int nM, nN, nwg, G, c, nkt;
    __device__ void init(int M, int N, int G_, int c_, int nkt_) { nM = M / BM; nN = N / BM; nwg = nM * nN; G = G_; c = c_; nkt = nkt_; }
    __device__ bool next(int i, Unit& u) const {
        const long L = (long)i * G + c; if (L >= nwg) return false;
        int wgid = (int)L; { const int q = nwg / NXCD, r = nwg % NXCD, xcd = wgid % NXCD, off = wgid / NXCD; wgid = (xcd < r ? xcd * (q + 1) : r * (q + 1) + (xcd - r) * q) + off; }
        const int nig = WGM * nN, gid = wgid / nig, fm = gid * WGM, gsz = (nM - fm) < WGM ? (nM - fm) : WGM;
        u.pm = fm + ((wgid % nig) % gsz); u.pn = (wgid % nig) / gsz; u.kt0 = 0; u.nkt = nkt; return true;
    }
};
struct SplitOrder {
    StaticOrder lat; int G, c, nkt, nsl;
    __device__ void init(int G_, int c_, int nkt_, bool ctx) { lat.init(MLAT, 1024, G_, c_, nkt_); G = G_; c = c_; nkt = nkt_; nsl = ctx ? 8 * (nkt_ >> 2) : 0; }
    __device__ bool next(int i, Unit& u) const {
        const long L = (long)i * G + c;
        if (L < lat.nwg) return lat.next(i, u);
        const int sidx = (int)(L - lat.nwg), S = nkt >> 2;
        if (sidx >= nsl) return false;
        const int t = sidx / S; u.pm = 128 + (t & 1); u.pn = t >> 1; u.kt0 = (sidx % S) * 4; u.nkt = 4; return true;
    }
};
__device__ __forceinline__ unsigned cvt_pk_bf16(float lo, float hi) { unsigned r; asm volatile("v_cvt_pk_bf16_f32 %0, %1, %2" : "=v"(r) : "v"(lo), "v"(hi)); return r; }

struct EpiSwiglu {
    bf16_t* O;
    __device__ __forceinline__ void operator()(const f32x4 (&acc)[2][2][4][2], const Unit& u, int wr, int wc, int fr, int fq) const {
        const int row0 = u.pm * BM + wr * 64 + fr, col0 = u.pn * 128 + wc * 32 + 8 * fq;
#pragma unroll
        for (int ai = 0; ai < 2; ++ai)
#pragma unroll
            for (int m = 0; m < 4; ++m) {
                const f32x4 g0 = acc[ai][0][m][0], g1 = acc[ai][0][m][1], u0 = acc[ai][1][m][0], u1 = acc[ai][1][m][1];
                u32x4 w;
                w.x = cvt_pk_bf16(siluf_(g0[0]) * u0[0], siluf_(g0[1]) * u0[1]); w.y = cvt_pk_bf16(siluf_(g0[2]) * u0[2], siluf_(g0[3]) * u0[3]);
                w.z = cvt_pk_bf16(siluf_(g1[0]) * u1[0], siluf_(g1[1]) * u1[1]); w.w = cvt_pk_bf16(siluf_(g1[2]) * u1[2], siluf_(g1[3]) * u1[3]);
                *(u32x4*)(O + (size_t)(row0 + ai * HALF + m * 16) * FFH + col0) = w;
            }
    }
};
struct EpiResid {
    float* h_lat; float* part; const float* gate; float coef;
    __device__ __forceinline__ void operator()(const f32x4 (&acc)[2][2][4][2], const Unit& u, int wr, int wc, int fr, int fq) const {
        const int row0 = u.pm * BM + wr * 64 + fr, col0 = u.pn * BM + wc * 32 + 8 * fq;
        const float* gp = gate + (u.pm < 64 ? 0 : (u.pm < 128 ? NMOD : 2 * NMOD));
        float* hb = (u.pm < 128) ? h_lat + (size_t)row0 * DM : part + ((size_t)(u.kt0 >> 2) * MCTX + (row0 - MLAT)) * DM;
#pragma unroll
        for (int bj = 0; bj < 2; ++bj)
#pragma unroll
            for (int n = 0; n < 2; ++n) {
                const int c = col0 + bj * HALF + 4 * n;
                const f32x4 gv = *(const f32x4*)(gp + c) * coef;
#pragma unroll
                for (int ai = 0; ai < 2; ++ai)
#pragma unroll
                    for (int m = 0; m < 4; ++m) {
                        float* p = hb + (size_t)(ai * HALF + m * 16) * DM + c;
                        const f32x4 dv = gv * acc[ai][bj][m][n];
                        if (u.pm < 128) *(f32x4*)p = *(const f32x4*)p + dv;
                        else *(f32x4*)p = dv;
                    }
            }
    }
};
template <int MODE, int LDC, int NCOL> struct EpiBf {
    bf16_t* O; const bf16_t* Yin; const float* bias;
    __device__ __forceinline__ void operator()(const f32x4 (&acc)[2][2][4][2], const Unit& u, int wr, int wc, int fr, int fq) const {
        const int row0 = u.pm * BM + wr * 64 + fr, col0 = u.pn * BM + wc * 32 + 8 * fq;
#pragma unroll
        for (int bj = 0; bj < 2; ++bj) {
            const int c = col0 + bj * HALF;
            if (c < NCOL) {
                f32x4 b0 = (f32x4){0.f, 0.f, 0.f, 0.f}, b1 = b0;
                if (MODE >= 3) { b0 = *(const f32x4*)(bias + c); b1 = *(const f32x4*)(bias + c + 4); }
#pragma unroll
                for (int ai = 0; ai < 2; ++ai)
#pragma unroll
                    for (int m = 0; m < 4; ++m) {
                        const int r = row0 + ai * HALF + m * 16;
                        f32x4 v0 = acc[ai][bj][m][0], v1 = acc[ai][bj][m][1];
                        if (MODE == 5) {
                            v0 += b0; v1 += b1;
#pragma unroll
                            for (int q = 0; q < 4; ++q) { v0[q] = sigmoidf_(v0[q]); v1[q] = sigmoidf_(v1[q]); }
                        } else if (MODE >= 3) {
                            v0 += b0; v1 += b1;
                            const u32x4 y = (MODE == 3) ? *(const u32x4*)(Yin + (size_t)r * 512 + c) : *(const u32x4*)(O + (size_t)r * LDC + c);
                            v0[0] = sigmoidf_(v0[0]) * bflo(y.x); v0[1] = sigmoidf_(v0[1]) * bfhi(y.x); v0[2] = sigmoidf_(v0[2]) * bflo(y.y); v0[3] = sigmoidf_(v0[3]) * bfhi(y.y);
                            v1[0] = sigmoidf_(v1[0]) * bflo(y.z); v1[1] = sigmoidf_(v1[1]) * bfhi(y.z); v1[2] = sigmoidf_(v1[2]) * bflo(y.w); v1[3] = sigmoidf_(v1[3]) * bfhi(y.w);
                        }
                        u32x4 w; w.x = cvt_pk_bf16(v0[0], v0[1]); w.y = cvt_pk_bf16(v0[2], v0[3]); w.z = cvt_pk_bf16(v1[0], v1[1]); w.w = cvt_pk_bf16(v1[2], v1[3]);
                        *(u32x4*)(O + (size_t)r * LDC + c) = w;
                    }
            }
        }
    }
};

struct EpiBranch {
    const bf16_t* G; bf16_t* Mo;
    __device__ __forceinline__ void operator()(const f32x4 (&acc)[2][2][4][2], const Unit& u, int wr, int wc, int fr, int fq) const {
        const int br = u.pn >> 2, row0 = u.pm * BM + wr * 64 + fr, col0 = (u.pn & 3) * BM + wc * 32 + 8 * fq;
#pragma unroll
        for (int bj = 0; bj < 2; ++bj) {
            const int c = col0 + bj * HALF;
#pragma unroll
            for (int ai = 0; ai < 2; ++ai)
#pragma unroll
                for (int m = 0; m < 4; ++m) {
                    const int r = row0 + ai * HALF + m * 16;
                    const u32x4 g = *(const u32x4*)(G + (size_t)r * 3072 + br * 1024 + c);
                    f32x4 v0 = acc[ai][bj][m][0], v1 = acc[ai][bj][m][1];
                    v0[0] *= bflo(g.x); v0[1] *= bfhi(g.x); v0[2] *= bflo(g.y); v0[3] *= bfhi(g.y); v1[0] *= bflo(g.z); v1[1] *= bfhi(g.z); v1[2] *= bflo(g.w); v1[3] *= bfhi(g.w);
                    bf16_t* mp = Mo + (size_t)r * 1024 + c;
                    if (br > 0) { const u32x4 p = *(const u32x4*)mp;
                        v0[0] += bflo(p.x); v0[1] += bfhi(p.x); v0[2] += bflo(p.y); v0[3] += bfhi(p.y); v1[0] += bflo(p.z); v1[1] += bfhi(p.z); v1[2] += bflo(p.w); v1[3] += bfhi(p.w); }
                    u32x4 w; w.x = cvt_pk_bf16(v0[0], v0[1]); w.y = cvt_pk_bf16(v0[2], v0[3]); w.z = cvt_pk_bf16(v1[0], v1[1]); w.w = cvt_pk_bf16(v1[2], v1[3]);
                    *(u32x4*)mp = w;
                }
        }
    }
};
struct BranchOrder {
    StaticOrder tl;
    __device__ void init(int M, int G_, int c_, int nkt_) { tl.init(M, 1024, G_, c_, nkt_); }
    __device__ bool next(int i, Unit& u) const { if (!tl.next(i / 3, u)) return false; u.pn += 4 * (i % 3); return true; }
};
template <class EpiT, class Sched, int K_, int LDA, int LDB, int ASH, int AKOFF>
__device__ __forceinline__ void gemm_phase(LAS unsigned char* lds, const Gemm g, const Sched& S, const EpiT& E) {
    const int tid = otid(), wid = __builtin_amdgcn_readfirstlane(tid >> 6), lane = tid & 63, wr = wid >> 2, wc = wid & 3, fr = lane & 15, fq = lane >> 4;
    constexpr int nt = K_ / BK;
    unsigned voffA[2], voffB[2];
#pragma unroll
    for (int i = 0; i < 2; ++i) { int R, C; stage_rc(tid * 16 + i * 8192, R, C); const int Rb = (R & ~31) + perm32(R & 31);
        voffA[i] = (unsigned)(R * LDA + C) * 2u; voffB[i] = (unsigned)(Rb * LDB + C) * 2u; }
    const size_t kstep = (size_t)(BK * 2);
    constexpr size_t hsA = (size_t)HALF * LDA * 2, hsB = (size_t)HALF * LDB * 2;
    constexpr size_t tsA = 2 * hsA, tsB = 2 * hsB;
    const unsigned ldsw = (unsigned)wid * 1024u;
    const int aoff = lds_byte(wr * 64 + fr, fq * 8), boff = lds_byte(wc * 32 + fr, fq * 8);
#define PG8_SA(b, h) (((b) * 2 + (h)) * HTB)
#define PG8_SB(b, h) ((4 + (b) * 2 + (h)) * HTB)
#define PG8_STAGE(bufoff, gbase, voff) do { _Pragma("unroll") for (int _i = 0; _i < 2; ++_i) \
        __builtin_amdgcn_global_load_lds((const unsigned*)((const char*)(gbase) + (voff)[_i]), (LAS unsigned*)(lds + (bufoff) + ldsw + _i * 8192), 16, 0, 0); } while (0)
#define PG8_LDA(dst, b, h) do { _Pragma("unroll") for (int m = 0; m < 4; ++m) _Pragma("unroll") for (int k = 0; k < 2; ++k) dst[m][k] = *(const LAS bf16x8*)(lds + PG8_SA(b, h) + aoff + m * 2048 + k * 1024); } while (0)
#define PG8_LDB(dst, b, h) do { _Pragma("unroll") for (int n = 0; n < 2; ++n) _Pragma("unroll") for (int k = 0; k < 2; ++k) dst[n][k] = *(const LAS bf16x8*)(lds + PG8_SB(b, h) + boff + n * 2048 + k * 1024); } while (0)
#define PG8_MMA(ai, bj, At, Bt) do { __builtin_amdgcn_s_setprio(1); _Pragma("unroll") for (int m = 0; m < 4; ++m) _Pragma("unroll") for (int n = 0; n < 2; ++n) _Pragma("unroll") for (int k = 0; k < 2; ++k) \
        acc[ai][bj][m][n] = __builtin_amdgcn_mfma_f32_16x16x32_bf16(Bt[n][k], At[m][k], acc[ai][bj][m][n], 0, 0, 0); __builtin_amdgcn_s_setprio(0); } while (0)
#define PG8_WAIT_V(n) asm volatile("s_waitcnt vmcnt(" #n ")" ::: "memory")
#define PG8_WAIT_L(n) asm volatile("s_waitcnt lgkmcnt(" #n ")" ::: "memory")
#define PG8_BAR __builtin_amdgcn_s_barrier()
#define PG8_SCHED __builtin_amdgcn_sched_barrier(0)
#define PG8_UA(u) ((const char*)g.A + (size_t)(u).pm * tsA + (size_t)(((u).pn >> ASH) * AKOFF) * 2 + (size_t)(u).kt0 * (BK * 2))
#define PG8_UB(u) ((const char*)g.Bt + (size_t)(u).pn * tsB + (size_t)(u).kt0 * (BK * 2))
    Unit cur, nxt; int ui = 0;
    if (!S.next(0, cur)) return;
    f32x4 acc[2][2][4][2];
#pragma unroll
    for (int a = 0; a < 2; ++a)
#pragma unroll
        for (int b = 0; b < 2; ++b)
#pragma unroll
            for (int m = 0; m < 4; ++m)
#pragma unroll
                for (int n = 0; n < 2; ++n) acc[a][b][m][n] = (f32x4){0.f, 0.f, 0.f, 0.f};
    bf16x8 At[4][2], B0[2][2], B1[2][2];
    const char* cA = PG8_UA(cur); const char* cB = PG8_UB(cur);
    PG8_STAGE(PG8_SB(0, 0), cB, voffB); PG8_STAGE(PG8_SB(0, 1), cB + hsB, voffB); PG8_STAGE(PG8_SA(0, 0), cA, voffA); PG8_STAGE(PG8_SA(0, 1), cA + hsA, voffA);
    if (wr == 1) PG8_BAR;
    PG8_WAIT_V(2); PG8_BAR;
    PG8_STAGE(PG8_SB(1, 0), cB + kstep, voffB); PG8_STAGE(PG8_SA(1, 0), cA + kstep, voffA); PG8_STAGE(PG8_SB(1, 1), cB + hsB + kstep, voffB);
    PG8_WAIT_V(6); PG8_BAR;
    for (;;) {
        const bool has_next = S.next(ui + 1, nxt);
        const char* nA = has_next ? PG8_UA(nxt) : cA; const char* nB = has_next ? PG8_UB(nxt) : cB;
        const int cnt = cur.nkt;
        for (int t = 0; t < cnt; t += 2) {
            const bool last = (t == cnt - 2);
            const char* a1 = cA + (size_t)(t + 1) * kstep;
            const char* a2 = last ? nA : cA + (size_t)(t + 2) * kstep; const char* b2 = last ? nB : cB + (size_t)(t + 2) * kstep;
            const char* a3 = a2 + kstep; const char* b3 = b2 + kstep;
            PG8_LDB(B0, 0, 0); PG8_LDB(B1, 0, 1); PG8_SCHED; PG8_LDA(At, 0, 0); PG8_STAGE(PG8_SA(1, 1), a1 + hsA, voffA);
            PG8_WAIT_V(8); PG8_WAIT_L(0); PG8_BAR; PG8_MMA(0, 0, At, B0); PG8_MMA(0, 1, At, B1); PG8_BAR; PG8_SCHED;
            PG8_LDA(At, 0, 1); PG8_STAGE(PG8_SB(0, 0), b2, voffB); PG8_STAGE(PG8_SB(0, 1), b2 + hsB, voffB); PG8_STAGE(PG8_SA(0, 0), a2, voffA);
            PG8_WAIT_V(8); PG8_WAIT_L(0); PG8_BAR; PG8_MMA(1, 0, At, B0); PG8_MMA(1, 1, At, B1); PG8_BAR; PG8_SCHED;
            PG8_LDB(B0, 1, 0); PG8_LDB(B1, 1, 1); PG8_SCHED; PG8_LDA(At, 1, 0); PG8_STAGE(PG8_SA(0, 1), a2 + hsA, voffA);
            PG8_WAIT_V(8); PG8_WAIT_L(0); PG8_BAR; PG8_MMA(0, 0, At, B0); PG8_MMA(0, 1, At, B1); PG8_BAR; PG8_SCHED;
            PG8_LDA(At, 1, 1); PG8_STAGE(PG8_SB(1, 0), b3, voffB); PG8_STAGE(PG8_SB(1, 1), b3 + hsB, voffB); PG8_STAGE(PG8_SA(1, 0), a3, voffA);
            PG8_WAIT_V(8); PG8_WAIT_L(0); PG8_BAR; PG8_MMA(1, 0, At, B0); PG8_MMA(1, 1, At, B1); PG8_BAR; PG8_SCHED;
        }
        if (wr == 0) PG8_BAR;
        E(acc, cur, wr, wc, fr, fq);
        if (!has_next) break;
#pragma unroll
        for (int a = 0; a < 2; ++a)
#pragma unroll
            for (int b = 0; b < 2; ++b)
#pragma unroll
                for (int m = 0; m < 4; ++m)
#pragma unroll
                    for (int n = 0; n < 2; ++n) acc[a][b][m][n] = (f32x4){0.f, 0.f, 0.f, 0.f};
        cur = nxt; cA = nA; cB = nB; ++ui;
        if (wr == 1) PG8_BAR;
    }
    PG8_WAIT_V(0);
    PG8_BAR;
#undef PG8_SA
#undef PG8_SB
#undef PG8_STAGE
#undef PG8_LDA
#undef PG8_LDB
#undef PG8_MMA
#undef PG8_WAIT_V
#undef PG8_WAIT_L
#undef PG8_BAR
#undef PG8_SCHED
#undef PG8_UA
#undef PG8_UB
}
}

namespace attn_body {
using bf16 = __hip_bfloat16;
using s16x4 = __attribute__((ext_vector_type(4))) short;
using f32x16 = __attribute__((ext_vector_type(16))) float;
constexpr int D = 64, NW = 8, QBLK = 32, QB = QBLK * NW, KVBLK = 64;
constexpr int QP = 512, KP = 128, VP = 128, OP = 1536;
__device__ __forceinline__ int crow(int r, int hi) { return (r & 3) + 8 * (r >> 2) + 4 * hi; }
#define SBAR() __builtin_amdgcn_sched_barrier(0)
constexpr int NSLOT = 3, SLOTB = 8192;
constexpr int LDS_K = 0, LDS_V = NSLOT * SLOTB, LDS_WS = 2 * NSLOT * SLOTB, LDS_OST = LDS_WS + NW * 64 * 4, ALDS_BYTES = LDS_OST + NW * 4096;
constexpr float C2 = 0.125f * 1.4426950408889634f;
__device__ __forceinline__ void glds16(const void* gsrc, unsigned lds_dst) { unsigned keep;
  asm volatile("s_mov_b32 %0, m0\n\ts_mov_b32 m0, %2\n\ts_nop 0\n\tglobal_load_lds_dwordx4 %1, off\n\ts_mov_b32 m0, %0" : "=&s"(keep) : "v"(gsrc), "s"(lds_dst) : "memory"); }
__device__ __forceinline__ float max3f(float a, float b, float c) { float r; asm("v_max3_f32 %0, %1, %2, %3" : "=v"(r) : "v"(a), "v"(b), "v"(c)); return r; }
__device__ __forceinline__ float max2f(float a, float b) { float r; asm("v_max_f32_e32 %0, %1, %2" : "=v"(r) : "v"(a), "v"(b)); return r; }
__device__ __forceinline__ float fadd_s(float a, float b) { float r; asm("v_add_f32_e32 %0, %1, %2" : "=v"(r) : "v"(a), "v"(b)); return r; }
__device__ __forceinline__ float fsub_s(float a, float b) { float r; asm("v_sub_f32_e32 %0, %1, %2" : "=v"(r) : "v"(a), "v"(b)); return r; }
typedef float f32x2_t __attribute__((ext_vector_type(2))); typedef __bf16 bf16x2_t __attribute__((ext_vector_type(2)));
__device__ __forceinline__ unsigned cvtpk_s(float lo, float hi) { f32x2_t v = {lo, hi}; bf16x2_t b = __builtin_convertvector(v, bf16x2_t); return __builtin_bit_cast(unsigned, b); }
#define WAIT_BAR(N) asm volatile("s_waitcnt vmcnt(" #N ") lgkmcnt(0)\n\ts_barrier" ::: "memory")
__device__ __forceinline__ void qkt(f32x16& p0, f32x16& p1, const char* Kslot, const bf16x8* qr, const f32x16& negm, int r32, int hi) {
  const char* kb = Kslot + hi * 1024 + r32 * 16;
  #pragma unroll
  for (int d0 = 0; d0 < 4; ++d0) {
    const bf16x8 b0 = *reinterpret_cast<const bf16x8*>(kb + d0 * 2048);
    const bf16x8 b1 = *reinterpret_cast<const bf16x8*>(kb + d0 * 2048 + 512);
    if (d0 == 0) { p0 = __builtin_amdgcn_mfma_f32_32x32x16_bf16(b0, qr[0], negm, 0, 0, 0); p1 = __builtin_amdgcn_mfma_f32_32x32x16_bf16(b1, qr[0], negm, 0, 0, 0); }
    else { p0 = __builtin_amdgcn_mfma_f32_32x32x16_bf16(b0, qr[d0], p0, 0, 0, 0); p1 = __builtin_amdgcn_mfma_f32_32x32x16_bf16(b1, qr[d0], p1, 0, 0, 0); } }
}
typedef __attribute__((address_space(3))) const char* lds_cptr;
typedef short v4i16_t __attribute__((ext_vector_type(4)));
__device__ __forceinline__ void kload8(bf16x8* kf, lds_cptr kp) {
  kf[0] = *(const LAS bf16x8*)(kp);        kf[1] = *(const LAS bf16x8*)(kp + 512);
  kf[2] = *(const LAS bf16x8*)(kp + 2048); kf[3] = *(const LAS bf16x8*)(kp + 2560);
  kf[4] = *(const LAS bf16x8*)(kp + 4096); kf[5] = *(const LAS bf16x8*)(kp + 4608);
  kf[6] = *(const LAS bf16x8*)(kp + 6144); kf[7] = *(const LAS bf16x8*)(kp + 6656);
}
__device__ __forceinline__ void kload2(bf16x8* kf, lds_cptr kp, int j) { kf[2 * j] = *(const LAS bf16x8*)(kp + j * 2048); kf[2 * j + 1] = *(const LAS bf16x8*)(kp + j * 2048 + 512); }
__device__ __forceinline__ s16x4 vtr(lds_cptr p) { return __builtin_bit_cast(s16x4, __builtin_amdgcn_ds_read_tr16_b64_v4i16((LAS v4i16_t*)p)); }
__device__ __forceinline__ float rowmax(const f32x16& p0, const f32x16& p1) {
  float a = max3f(p0[0], p0[1], p1[0]), b = max3f(p0[2], p0[3], p1[1]); a = max3f(a, p1[2], p1[3]);
  #pragma unroll
  for (int r = 4; r < 16; r += 4) { a = max3f(a, p0[r], p0[r + 1]); b = max3f(b, p0[r + 2], p0[r + 3]); a = max3f(a, p1[r], p1[r + 1]); b = max3f(b, p1[r + 2], p1[r + 3]); }
  const float m = max2f(a, b);
  auto rr = __builtin_amdgcn_permlane32_swap(__float_as_uint(m), __float_as_uint(m), false, false);
  return max2f(__uint_as_float(rr[0]), __uint_as_float(rr[1]));
}
__device__ __forceinline__ void pv(f32x16* o, int vb, bf16x8 pa0, bf16x8 pa1, bf16x8 pa2, bf16x8 pa3) {
  #pragma unroll
  for (int d0 = 0; d0 < 2; ++d0) { s16x4 lo[4], hi[4];
    #pragma unroll
    for (int ks = 0; ks < 4; ++ks) {
      asm volatile("ds_read_b64_tr_b16 %0,%1 offset:%c2" : "=&v"(lo[ks]) : "v"(vb), "i"(d0 * 4096 + ks * 1024) : "memory");
      asm volatile("ds_read_b64_tr_b16 %0,%1 offset:%c2" : "=&v"(hi[ks]) : "v"(vb), "i"(d0 * 4096 + ks * 1024 + 512) : "memory"); }
    asm volatile("s_waitcnt lgkmcnt(0)" ::: "memory"); SBAR();
    #define PK(k) (bf16x8){lo[k][0], lo[k][1], lo[k][2], lo[k][3], hi[k][0], hi[k][1], hi[k][2], hi[k][3]}
    o[d0] = __builtin_amdgcn_mfma_f32_32x32x16_bf16(pa0, PK(0), o[d0], 0, 0, 0);
    o[d0] = __builtin_amdgcn_mfma_f32_32x32x16_bf16(pa1, PK(1), o[d0], 0, 0, 0);
    o[d0] = __builtin_amdgcn_mfma_f32_32x32x16_bf16(pa2, PK(2), o[d0], 0, 0, 0);
    o[d0] = __builtin_amdgcn_mfma_f32_32x32x16_bf16(pa3, PK(3), o[d0], 0, 0, 0);
    #undef PK
  }
}
template <int THRL> __device__ __forceinline__ void attn_unit(const bf16* Qu, const bf16* __restrict__ Kh, const bf16* __restrict__ Vh, bf16* Ou, const int NT, char* shm) {
  const int tid = otid(), lane = tid & 63, r32 = lane & 31, hi = lane >> 5; const int wid = __builtin_amdgcn_readfirstlane(tid >> 6);
  const bf16* Qw = Qu + (long)(wid * QBLK) * QP;
  const unsigned lds0 = (unsigned)(uintptr_t)shm;
  float* wsf = (float*)(shm + LDS_WS) + wid * 64;
  const bf16* ksrc = Kh + (long)lane * KP + wid * 8;
  const bf16* vsrc = Vh + (long)(16 * (wid & 3) + (lane >> 2)) * VP + (wid >> 2) * 32 + (lane & 3) * 8;
  const unsigned kdst = lds0 + LDS_K + wid * 1024, vdst = lds0 + LDS_V + wid * 1024;
  #define DMA_K(t, slot) glds16(ksrc + (long)(t) * KVBLK * KP, (unsigned)__builtin_amdgcn_readfirstlane(kdst + (slot)))
  #define DMA_V(t, slot) glds16(vsrc + (long)(t) * KVBLK * VP, (unsigned)__builtin_amdgcn_readfirstlane(vdst + (slot)))
  const int vb0 = (int)(lds0 + LDS_V) + ((lane >> 4) & 1) * 32 + (lane & 3) * 8 + (4 * hi + ((lane & 15) >> 2)) * 64;
  const char* Kbase = shm + LDS_K; bf16x8 kf[8];
  const lds_cptr shm3 = (lds_cptr)shm; const lds_cptr kp0 = shm3 + LDS_K + hi * 1024 + r32 * 16; const lds_cptr vp0 = shm3 + LDS_V + ((lane >> 4) & 1) * 32 + (lane & 3) * 8 + (4 * hi + ((lane & 15) >> 2)) * 64;
  DMA_K(0, 0); DMA_V(0, 0); DMA_K(1, SLOTB);
  bf16x8 qr[4];
  #pragma unroll
  for (int d0 = 0; d0 < 4; ++d0) qr[d0] = *reinterpret_cast<const bf16x8*>(&Qw[(long)r32 * QP + d0 * 16 + hi * 8]);
  float mhat = 0.f, l_reg = 0.f; f32x16 o[2]; o[0] = f32x16{}; o[1] = f32x16{}; f32x16 negm = f32x16{}; asm volatile("" : "+v"(negm));
  bool resc = false;
  #define START(P0, P1) do { const float rm = rowmax(P0, P1); resc = false; \
    { const float dl = rm; mhat = fadd_s(mhat, dl); \
      _Pragma("unroll") for (int r = 0; r < 16; ++r) { P0[r] = fsub_s(P0[r], dl); P1[r] = fsub_s(P1[r], dl); } \
      _Pragma("unroll") for (int r = 0; r < 16; ++r) negm[r] = -mhat; asm volatile("" : "+v"(negm)); } \
    _Pragma("unroll") for (int r = 0; r < 16; ++r) P0[r] = __builtin_amdgcn_exp2f(P0[r]); } while (0)
  #define RESC() do { if (resc) { asm volatile("s_waitcnt lgkmcnt(0)" ::: "memory"); \
      _Pragma("unroll") for (int d_ = 0; d_ < 2; ++d_) _Pragma("unroll") for (int r = 0; r < 16; ++r) o[d_][r] *= wsf[crow(r, hi)]; } } while (0)
  f32x16 pA0, pA1, pB0, pB1;
  int sl_prev = 0, sl_cur = 0, sl_next = SLOTB;
  #define ROT() do { sl_prev = sl_cur; sl_cur = sl_next; sl_next = (sl_next == (NSLOT - 1) * SLOTB) ? 0 : sl_next + SLOTB; } while (0)
  DMA_K(2, 2 * SLOTB);
  WAIT_BAR(3);
  qkt(pA0, pA1, Kbase, qr, negm, r32, hi); asm volatile("s_nop 15\n\ts_nop 7" : "+v"(pA0), "+v"(pA1));
  START(pA0, pA1);
  _Pragma("unroll") for (int r = 0; r < 16; ++r) pA1[r] = __builtin_amdgcn_exp2f(pA1[r]);
  WAIT_BAR(0);
  DMA_K(3, 0); DMA_V(1, SLOTB);
  ROT();
  kload8(kf, kp0 + sl_cur);
  WAIT_BAR(2);
  s16x4 vlo[8], vhi[8]; u32x4 pw0, pw1, pw2, pw3;
  #define PKW(P, B) cvtpk_s(P[B], P[B + 1])
  #define PAF(k) __builtin_bit_cast(bf16x8, pw##k)
  #define VFR(i) (bf16x8){vlo[i][0], vlo[i][1], vlo[i][2], vlo[i][3], vhi[i][0], vhi[i][1], vhi[i][2], vhi[i][3]}
  #define PIN(x) asm volatile("" : "+v"(x))
  #define MX3(a, b, c) __builtin_fmaxf(__builtin_fmaxf((a), (b)), (c))
  #define GAPA(MF, A0, A1, A2, A3, W0, W1, PW) do { MF; sacc += A0; sacc += A1; sacc += A2; sacc += A3; PIN(sacc); W0; W1; PIN(PW); SBAR(); } while (0)
  #define EX(v) __builtin_amdgcn_exp2f(v)
  #define GAPB(MF, X, B) do { MF; X[B] = EX(X[B]); X[B + 1] = EX(X[B + 1]); X[B + 2] = EX(X[B + 2]); X[B + 3] = EX(X[B + 3]); PIN(X); SBAR(); } while (0)
  #define VRD(i) do { vlo[i] = vtr(vp_ + (((i) >> 2) * 4096 + ((i) & 3) * 1024)); vhi[i] = vtr(vp_ + (((i) >> 2) * 4096 + ((i) & 3) * 1024 + 512)); } while (0)
  #define KRD(G, j) do { if (G) { kload2(kf, kp0 + sl_next, j); SBAR(); } } while (0)
  #define STEP(C0, C1, P0, P1, t, GK, GV, GL) do { SBAR(); \
    const lds_cptr vp_ = vp0 + sl_prev; \
    VRD(0); SBAR(); float sacc = (P0[0] + P0[1]); \
    GAPA(C0 = __builtin_amdgcn_mfma_f32_32x32x16_bf16(kf[0], qr[0], negm, 0, 0, 0), P0[2], P0[3], P0[4], P0[5],     pw0[0] = PKW(P0, 0), pw0[1] = PKW(P0, 2), pw0); \
    VRD(4); SBAR(); GAPA(C1 = __builtin_amdgcn_mfma_f32_32x32x16_bf16(kf[1], qr[0], negm, 0, 0, 0), P0[6], P0[7], P0[8], P0[9],     pw0[2] = PKW(P0, 4), pw0[3] = PKW(P0, 6), pw0); \
    VRD(1); SBAR(); GAPA(C0 = __builtin_amdgcn_mfma_f32_32x32x16_bf16(kf[2], qr[1], C0, 0, 0, 0),   P0[10], P0[11], P0[12], P0[13], pw1[0] = PKW(P0, 8), pw1[1] = PKW(P0, 10), pw1); \
    VRD(5); SBAR(); GAPA(C1 = __builtin_amdgcn_mfma_f32_32x32x16_bf16(kf[3], qr[1], C1, 0, 0, 0),   P0[14], P0[15], P1[0], P1[1],   pw1[2] = PKW(P0, 12), pw1[3] = PKW(P0, 14), pw1); \
    VRD(2); SBAR(); GAPA(C0 = __builtin_amdgcn_mfma_f32_32x32x16_bf16(kf[4], qr[2], C0, 0, 0, 0),   P1[2], P1[3], P1[4], P1[5],     pw2[0] = PKW(P1, 0), pw2[1] = PKW(P1, 2), pw2); \
    VRD(6); SBAR(); GAPA(C1 = __builtin_amdgcn_mfma_f32_32x32x16_bf16(kf[5], qr[2], C1, 0, 0, 0),   P1[6], P1[7], P1[8], P1[9],     pw2[2] = PKW(P1, 4), pw2[3] = PKW(P1, 6), pw2); \
    VRD(3); SBAR(); GAPA(C0 = __builtin_amdgcn_mfma_f32_32x32x16_bf16(kf[6], qr[3], C0, 0, 0, 0),   P1[10], P1[11], P1[12], P1[13], pw3[0] = PKW(P1, 8), pw3[1] = PKW(P1, 10), pw3); \
    VRD(7); SBAR(); GAPA(C1 = __builtin_amdgcn_mfma_f32_32x32x16_bf16(kf[7], qr[3], C1, 0, 0, 0),   P1[14], P1[15], 0.f, 0.f,       pw3[2] = PKW(P1, 12), pw3[3] = PKW(P1, 14), pw3); \
    l_reg += sacc; \
    if (GK) { DMA_K((t) + 3, sl_cur); } if (GV) { DMA_V((t) + 1, sl_next); } \
    { float a = MX3(C0[0], C0[1], C1[0]), b = MX3(C0[2], C0[3], C1[1]); a = MX3(a, C1[2], C1[3]); \
      _Pragma("unroll") for (int r = 4; r < 16; r += 4) { a = MX3(a, C0[r], C0[r + 1]); b = MX3(b, C0[r + 2], C0[r + 3]); a = MX3(a, C1[r], C1[r + 1]); b = MX3(b, C1[r + 2], C1[r + 3]); } \
      float rm = __builtin_fmaxf(a, b); { auto rr = __builtin_amdgcn_permlane32_swap(__float_as_uint(rm), __float_as_uint(rm), false, false); rm = __builtin_fmaxf(__uint_as_float(rr[0]), __uint_as_float(rr[1])); } \
      resc = false; \
      if (__builtin_expect(__any(rm > (float)THRL), 0)) { const float dl = __builtin_fmaxf(rm, 0.f); mhat += dl; \
        _Pragma("unroll") for (int r = 0; r < 16; ++r) { C0[r] -= dl; C1[r] -= dl; } \
        _Pragma("unroll") for (int r = 0; r < 16; ++r) negm[r] = -mhat; asm volatile("" : "+v"(negm)); \
        const float f = __builtin_amdgcn_exp2f(-dl); l_reg *= f; if (hi == 0) wsf[r32] = f; resc = true; } } \
    SBAR(); \
    GAPB(o[0] = __builtin_amdgcn_mfma_f32_32x32x16_bf16(PAF(0), VFR(0), o[0], 0, 0, 0), C0, 0); \
    GAPB(o[1] = __builtin_amdgcn_mfma_f32_32x32x16_bf16(PAF(0), VFR(4), o[1], 0, 0, 0), C0, 4); \
    KRD(GL, 0); GAPB(o[0] = __builtin_amdgcn_mfma_f32_32x32x16_bf16(PAF(1), VFR(1), o[0], 0, 0, 0), C0, 8); \
    KRD(GL, 1); GAPB(o[1] = __builtin_amdgcn_mfma_f32_32x32x16_bf16(PAF(1), VFR(5), o[1], 0, 0, 0), C0, 12); \
    KRD(GL, 2); GAPB(o[0] = __builtin_amdgcn_mfma_f32_32x32x16_bf16(PAF(2), VFR(2), o[0], 0, 0, 0), C1, 0); \
    KRD(GL, 3); GAPB(o[1] = __builtin_amdgcn_mfma_f32_32x32x16_bf16(PAF(2), VFR(6), o[1], 0, 0, 0), C1, 4); \
    GAPB(o[0] = __builtin_amdgcn_mfma_f32_32x32x16_bf16(PAF(3), VFR(3), o[0], 0, 0, 0), C1, 8); \
    GAPB(o[1] = __builtin_amdgcn_mfma_f32_32x32x16_bf16(PAF(3), VFR(7), o[1], 0, 0, 0), C1, 12); \
    } while (0)
  int t = 1;
  for (; t + 5 < NT; t += 2) {
    STEP(pB0, pB1, pA0, pA1, t, true, true, true);     WAIT_BAR(2); RESC(); ROT();
    STEP(pA0, pA1, pB0, pB1, t + 1, true, true, true); WAIT_BAR(2); RESC(); ROT();
  }
  #define ENDW(tt) do { if ((tt) + 3 < NT) { WAIT_BAR(2); } else if ((tt) + 2 < NT) { WAIT_BAR(1); } else { WAIT_BAR(0); } } while (0)
  for (; t + 1 < NT; t += 2) {
    STEP(pB0, pB1, pA0, pA1, t, (t + 3 < NT), (t + 1 < NT), (t + 1 < NT));         ENDW(t);     RESC(); ROT();
    STEP(pA0, pA1, pB0, pB1, t + 1, (t + 4 < NT), (t + 2 < NT), (t + 2 < NT));     ENDW(t + 1); RESC(); ROT();
  }
  STEP(pB0, pB1, pA0, pA1, NT - 1, false, false, false); RESC();
  { float sacc = pB0[0] + pB0[1]; _Pragma("unroll") for (int r = 2; r < 16; ++r) sacc += pB0[r]; _Pragma("unroll") for (int r = 0; r < 16; ++r) sacc += pB1[r]; l_reg += sacc;
    pw0 = (u32x4){PKW(pB0, 0), PKW(pB0, 2), PKW(pB0, 4), PKW(pB0, 6)}; pw1 = (u32x4){PKW(pB0, 8), PKW(pB0, 10), PKW(pB0, 12), PKW(pB0, 14)}; pw2 = (u32x4){PKW(pB1, 0), PKW(pB1, 2), PKW(pB1, 4), PKW(pB1, 6)}; pw3 = (u32x4){PKW(pB1, 8), PKW(pB1, 10), PKW(pB1, 12), PKW(pB1, 14)};
    SBAR(); pv(o, vb0 + sl_cur, PAF(0), PAF(1), PAF(2), PAF(3)); }
  #undef PKW
  #undef PAF
  #undef VFR
  #undef PIN
  #undef MX3
  #undef GAPA
  #undef GAPB
  #undef EX
  #undef VRD
  #undef KRD
  #undef STEP
  #undef ENDW
  { auto rr = __builtin_amdgcn_permlane32_swap(__float_as_uint(l_reg), __float_as_uint(l_reg), false, false); l_reg = __uint_as_float(rr[0]) + __uint_as_float(rr[1]); }
  if (hi == 0) wsf[32 + r32] = l_reg; asm volatile("s_waitcnt lgkmcnt(0)" ::: "memory");
  float rli[16];
  #pragma unroll
  for (int r = 0; r < 16; ++r) rli[r] = __builtin_amdgcn_rcpf(wsf[32 + crow(r, hi)]);
  bf16* Ow = Ou + (long)(wid * QBLK) * OP;
  { bf16* stg = (bf16*)(shm + LDS_OST) + wid * 2048;
    #pragma unroll
    for (int r = 0; r < 16; ++r) { const int orow = crow(r, hi);
      #pragma unroll
      for (int d0 = 0; d0 < 2; ++d0) stg[orow * 64 + d0 * 32 + r32] = __float2bfloat16(o[d0][r] * rli[r]); }
    asm volatile("s_waitcnt lgkmcnt(0)" ::: "memory");
    #pragma unroll
    for (int i = 0; i < 4; ++i) { const int row = i * 8 + (lane >> 3), ch = lane & 7; const u32x4 v = *(const u32x4*)(stg + row * 64 + ch * 8); *(u32x4*)(Ow + (long)row * OP + ch * 8) = v; } }
  asm volatile("s_waitcnt lgkmcnt(0)\n\ts_barrier" ::: "memory");
  #undef DMA_K
  #undef DMA_V
  #undef START
  #undef RESC
  #undef ROT
}
#undef SBAR
#undef WAIT_BAR
}

__device__ __forceinline__ f32x4 mm_tile(const LAS bf16_t* X, int ldx, const LAS bf16_t* Y, int ldy, int K, int lane, f32x4 acc) {
    const LAS bf16_t* xp = X + (lane & 15) * ldx + (lane >> 4) * 8;
    const LAS bf16_t* yp = Y + (lane & 15) * ldy + (lane >> 4) * 8;
    for (int k = 0; k < K; k += 32) {
        const bf16x8 a = *(const LAS bf16x8*)(xp + k), b = *(const LAS bf16x8*)(yp + k);
        acc = __builtin_amdgcn_mfma_f32_16x16x32_bf16(a, b, acc, 0, 0, 0);
    }
    return acc;
}

__device__ __forceinline__ int win_map(int n) { return n < 768 ? n + 2080 : (n < 1792 ? n - 768 : (n < 2816 ? n - 736 : (n < 2848 ? n - 1792 : -1))); }
__device__ __forceinline__ const float* wsrc_ptr(const AP& a, int mat, int li, int k, int n, size_t& rs) {
    switch (mat) {
        case 0: case 1: { const int pn = n >> 8, w = n & 255; const float* W = (w < 128) ? a.in[7] : a.in[8]; rs = FFH; return W + ((size_t)(li * 2 + mat) * 1024 + k) * FFH + pn * 128 + (w & 127); }
        case 2: case 3: rs = 1024; return a.in[9] + ((size_t)(li * 2 + mat - 2) * FFH + k) * 1024 + n;
        case 4: { const int o = win_map(n); rs = ZP; return o < 0 ? nullptr : a.in[10] + ((size_t)li * 1024 + k) * ZP + o; }
        case 5: rs = 3072; return a.in[26] + ((size_t)li * 1024 + k) * 3072 + n;
        case 6: rs = 1024; return a.in[28] + (((size_t)li * 3 + (n >> 10)) * 512 + k) * 1024 + (n & 1023);
        case 7: rs = 1024; return a.in[29] + ((size_t)li * 1024 + (k & 1023)) * 1024 + n;
        default: rs = 512; return a.in[22] + ((size_t)li * 512 + k) * 512 + n;
    }
}
__device__ __forceinline__ void tables_phase(const AP& args, LAS unsigned char* lds) {
    const int tid = otid(), G = gridDim.x;
    unsigned char* ws = args.ws;
    const int gt = blockIdx.x * 512 + tid, NTH = G * 512;
    {
        LAS float* sv = (LAS float*)lds;
        LAS float* red = sv + 3072;
        for (int i = tid; i < 3072; i += 512) { const int g = i >> 10, k = i & 1023; const float v = g < 2 ? args.in[1][g * 1024 + k] : args.in[3][k]; sv[i] = siluf_(v); }
        __syncthreads();
        for (int it = blockIdx.x; it < 288; it += G) {
            const int l = it / 144, c0 = (it % 144) * 64, col = tid & 63, ks = tid >> 6;
            const float* W = args.in[4] + (size_t)l * 1024 * NMOD + c0 + col;
            float a0 = 0.f, a1 = 0.f, a2 = 0.f;
#pragma unroll 16
            for (int k = ks * 128; k < ks * 128 + 128; ++k) { const float w = W[(size_t)k * NMOD]; a0 += sv[k] * w; a1 += sv[1024 + k] * w; a2 += sv[2048 + k] * w; }
            red[(ks * 64 + col) * 3 + 0] = a0; red[(ks * 64 + col) * 3 + 1] = a1; red[(ks * 64 + col) * 3 + 2] = a2;
            __syncthreads();
            if (tid < 192) { const int g = tid >> 6, c = tid & 63; float s = args.in[5][l * NMOD + c0 + c];
                for (int q = 0; q < 8; ++q) s += red[(q * 64 + c) * 3 + g];
                ((float*)(ws + WS_MODS))[(l * 3 + g) * NMOD + c0 + c] = s; }
            __syncthreads();
        }
        for (int i = gt; i < 4096; i += NTH) { const int pos = i >> 4, j = i & 15; const float inv = powf(10000.f, -(float)j / 16.f); const float ang = (float)pos * inv;
            ((float*)(ws + WS_ROPE))[2 * i] = (float)cos((double)ang); ((float*)(ws + WS_ROPE))[2 * i + 1] = (float)sin((double)ang); }
    }
    for (int i0 = gt; i0 < 8192; i0 += NTH) {
        const int li = i0 >> 12, i = i0 & 4095, dir = i >> 11, g = (i >> 6) & 31, p = i & 63;
        const double dt = exp((double)args.in[16][(li * 2 + dir) * 32 + g]);
        const double ar = args.in[14][((li * 2 + dir) * 32 + g) * 64 + p], ai = args.in[15][((li * 2 + dir) * 32 + g) * 64 + p];
        const double mag = exp(dt * ar), are = mag * cos(dt * ai), aim = mag * sin(dt * ai);
        const double den = ar * ar + ai * ai, xr = are - 1.0, xi = aim;
        const double cre = (xr * ar + xi * ai) / den, cim = (xi * ar - xr * ai) / den;
        double pr = are, pi = aim;
        for (int q = 0; q < 6; ++q) { const double nr = pr * pr - pi * pi, ni = 2.0 * pr * pi; pr = nr; pi = ni; }
        float* A = (float*)(ws + WS_S5A) + (size_t)i0 * 4; A[0] = (float)are; A[1] = (float)aim; A[2] = (float)pr; A[3] = (float)pi;
        bf16_t* B = (bf16_t*)(ws + WS_S5B) + ((size_t)((li * 2 + dir) * 32 + g) * 128 + 2 * p) * 16;
        const float* bre = args.in[17] + ((size_t)(li * 32 + g) * 64 + p) * 16; const float* bim = args.in[18] + ((size_t)(li * 32 + g) * 64 + p) * 16;
        for (int c = 0; c < 16; ++c) { const double br = bre[c], bi = bim[c]; B[c] = (bf16_t)f2bf((float)(cre * br - cim * bi)); B[16 + c] = (bf16_t)f2bf((float)(cre * bi + cim * br)); }
    }
    for (int i0 = gt; i0 < 65536; i0 += NTH) { const int li = i0 >> 15, i = i0 & 32767, g = i >> 10, c = (i >> 6) & 15, p = i & 63;
        bf16_t* C = (bf16_t*)(ws + WS_S5C) + (size_t)((li * 32 + g) * 16 + c) * 128 + 2 * p;
        C[0] = (bf16_t)f2bf(args.in[19][((size_t)(li * 32 + g) * 16 + c) * 64 + p]); C[1] = (bf16_t)f2bf(-args.in[20][((size_t)(li * 32 + g) * 16 + c) * 64 + p]); }
}
__device__ __forceinline__ void prep_phase(const AP& args, int li, LAS unsigned char* lds) {
    const int tid = otid(), lane = tid & 63, wave = tid >> 6, G = gridDim.x;
    unsigned char* ws = args.ws;
    LAS float* scr = (LAS float*)(lds + wave * 16384);
    const int gw = blockIdx.x * 8 + wave, NGW = G * 8;
    constexpr int I0 = 2816, I2 = 1408, I4 = 1536, I6 = 768, I7 = 512, I8 = 128;
    constexpr int NIT = 2 * I0 + 2 * I2 + 2 * I4 + I6 + I7 + I8;
    __syncthreads();
    for (int it = gw; it < NIT; it += NGW) {
        int r = it, mat, N, K; size_t woff;
        if (r < I0) { mat = 0; N = 5632; K = 1024; woff = W_GU; }
        else if ((r -= I0) < I0) { mat = 1; N = 5632; K = 1024; woff = W_GU + 5632ull * 1024 * 2; }
        else if ((r -= I0) < I2) { mat = 2; N = 1024; K = FFH; woff = W_DN; }
        else if ((r -= I2) < I2) { mat = 3; N = 1024; K = FFH; woff = W_DN + 1024ull * FFH * 2; }
        else if ((r -= I2) < I4) { mat = 4; N = 3072; K = 1024; woff = W_IN; }
        else if ((r -= I4) < I4) { mat = 5; N = 3072; K = 1024; woff = W_BG; }
        else if ((r -= I4) < I6) { mat = 6; N = 3072; K = 512; woff = W_PJ; }
        else if ((r -= I6) < I7) { mat = 7; N = 1024; K = 1024; woff = W_O3; }
        else { r -= I7; mat = 8; N = 512; K = 512; woff = W_GL; }
        bf16_t* WT = (bf16_t*)(ws + WS_W + woff);
        const int nblk = N / 32, kb = r / nblk, nb = r % nblk, k0 = 64 * kb, n0 = 32 * nb;
        size_t rs; const float* sp = wsrc_ptr(args, mat, li, k0 + (lane >> 5), n0 + (lane & 31), rs);
#pragma unroll 16
        for (int i = 0; i < 32; ++i) { const int kk = 2 * i + (lane >> 5); scr[kk * 33 + (lane & 31)] = sp ? sp[(size_t)(2 * i) * rs] : 0.f; }
        LDS_WAIT(); asm volatile("" ::: "memory");
        const int c = lane & 7;
#pragma unroll
        for (int j = 0; j < 4; ++j) { const int n = (lane >> 3) + 8 * j; const LAS float* s = scr + (8 * c) * 33 + n;
            u32x4 o; o.x = pk2(s[0 * 33], s[1 * 33]); o.y = pk2(s[2 * 33], s[3 * 33]); o.z = pk2(s[4 * 33], s[5 * 33]); o.w = pk2(s[6 * 33], s[7 * 33]);
            *(u32x4*)(WT + (size_t)(n0 + n) * K + k0 + 8 * c) = o; }
        LDS_WAIT(); asm volatile("" ::: "memory");
    }
}

__device__ __forceinline__ void norm_phase(const float* src_lat, const float* rd_ctx, float* cp_lat, float* src_ctx, const float* nw, const float* mods, int si, bf16_t* XN, const float* part, int npart) {
    const int tid_ = otid(), lane = tid_ & 63, gw = blockIdx.x * 8 + (tid_ >> 6), NGW = gridDim.x * 8;
    for (int r = gw; r < MT; r += NGW) {
        const float* xr = r < MLAT ? src_lat + (size_t)r * DM : rd_ctx + (size_t)(r - MLAT) * DM;
        const int grp = r < SEQL ? 0 : (r < MLAT ? 1 : 2);
        const float* sh = mods + grp * NMOD + si * DM; const float* sc = sh + DM;
        f32x4 v[4]; float s = 0.f;
#pragma unroll
        for (int j = 0; j < 4; ++j) v[j] = *(const f32x4*)(xr + 4 * (lane + 64 * j));
        if (r >= MLAT && npart > 0) {
            for (int q = 0; q < npart; ++q) { const float* pr = part + ((size_t)q * MCTX + (r - MLAT)) * DM;
#pragma unroll
                for (int j = 0; j < 4; ++j) v[j] += *(const f32x4*)(pr + 4 * (lane + 64 * j)); }
#pragma unroll
            for (int j = 0; j < 4; ++j) *(f32x4*)(src_ctx + (size_t)(r - MLAT) * DM + 4 * (lane + 64 * j)) = v[j];
        } else if (cp_lat) {
            float* cr = r < MLAT ? cp_lat + (size_t)r * DM : src_ctx + (size_t)(r - MLAT) * DM;
#pragma unroll
            for (int j = 0; j < 4; ++j) *(f32x4*)(cr + 4 * (lane + 64 * j)) = v[j];
        }
#pragma unroll
        for (int j = 0; j < 4; ++j) s += (v[j].x * v[j].x + v[j].y * v[j].y) + (v[j].z * v[j].z + v[j].w * v[j].w);
        const float rs = 1.0f / sqrtf(wave_sum(s) * (1.f / DM) + EPS);
#pragma unroll
        for (int j = 0; j < 4; ++j) { const int c = 4 * (lane + 64 * j);
            const f32x4 w = *(const f32x4*)(nw + c), a = *(const f32x4*)(sc + c), b = *(const f32x4*)(sh + c);
            const f32x4 y = (v[j] * rs * w) * (a + 1.0f) + b;
            u32x2 o; o.x = pk2(y.x, y.y); o.y = pk2(y.z, y.w);
            *(u32x2*)(XN + (size_t)r * DM + c) = o; }
    }
}

__device__ __forceinline__ void attn_prep(const AP& args, int li) {
    unsigned char* ws = args.ws;
    const bf16_t* Z = (const bf16_t*)(ws + WS_A);
    bf16_t* Qb = (bf16_t*)(ws + WS_QB); bf16_t* Kb = (bf16_t*)(ws + WS_KB); bf16_t* Vb = (bf16_t*)(ws + WS_VB);
    const float* rope = (const float*)(ws + WS_ROPE);
    const int tid_ = otid(), lane = tid_ & 63, gw = blockIdx.x * 8 + (tid_ >> 6), NGW = gridDim.x * 8;
    const int hq = lane >> 3, sub = lane & 7, ax = sub >> 2, j0 = 4 * (sub & 3), d1 = ax * 32 + j0;
    const f32x4 qw1 = *(const f32x4*)(args.in[24] + li * 64 + d1), qw2 = *(const f32x4*)(args.in[24] + li * 64 + d1 + 16);
    const f32x4 kw1 = *(const f32x4*)(args.in[25] + li * 64 + d1), kw2 = *(const f32x4*)(args.in[25] + li * 64 + d1 + 16);
    for (int r = gw; r < MT; r += NGW) {
        const bf16_t* zr = Z + (size_t)r * ZP;
        int b, kpos; f32x4 ra = (f32x4){1.f, 0.f, 1.f, 0.f}, rb = ra;
        if (r < MLAT) { b = r >> 14; const int t = r & (SEQL - 1); kpos = CTXL + t; const int pos = ax ? (t & 63) : (t >> 6);
            ra = *(const f32x4*)(rope + (pos * 16 + j0) * 2); rb = *(const f32x4*)(rope + (pos * 16 + j0) * 2 + 4); }
        else { b = (r - MLAT) >> 8; kpos = (r - MLAT) & 255; }
        const float cs[4] = {ra.x, ra.z, rb.x, rb.z}, sn[4] = {ra.y, ra.w, rb.y, rb.w};
#pragma unroll
        for (int pass = 0; pass < 2; ++pass) {
            const int hh = pass ? (8 + (hq & 1)) : hq;
            const u32x2 w1 = *(const u32x2*)(zr + hh * 64 + d1), w2 = *(const u32x2*)(zr + hh * 64 + d1 + 16);
            const float t1[4] = {bflo(w1.x), bfhi(w1.x), bflo(w1.y), bfhi(w1.y)}, t2[4] = {bflo(w2.x), bfhi(w2.x), bflo(w2.y), bfhi(w2.y)};
            float ss = 0.f;
#pragma unroll
            for (int i = 0; i < 4; ++i) ss += t1[i] * t1[i] + t2[i] * t2[i];
            ss += __shfl_xor(ss, 1); ss += __shfl_xor(ss, 2); ss += __shfl_xor(ss, 4);
            const float rs = (1.0f / sqrtf(ss * (1.f / 64.f) + EPS)) * (pass ? 1.f : attn_body::C2);
            const f32x4 wa = pass ? kw1 : qw1, wb = pass ? kw2 : qw2;
            float o1[4], o2[4];
#pragma unroll
            for (int i = 0; i < 4; ++i) { const float y1 = t1[i] * rs * wa[i], y2 = t2[i] * rs * wb[i]; o1[i] = y1 * cs[i] - y2 * sn[i]; o2[i] = y2 * cs[i] + y1 * sn[i]; }
            u32x2 p1, p2; p1.x = pk2(o1[0], o1[1]); p1.y = pk2(o1[2], o1[3]); p2.x = pk2(o2[0], o2[1]); p2.y = pk2(o2[2], o2[3]);
            if (pass == 0) { bf16_t* q = Qb + (size_t)r * 512 + hq * 64 + d1; *(u32x2*)q = p1; *(u32x2*)(q + 16) = p2; }
            else if (lane < 16) { bf16_t* k = Kb + ((size_t)b * KVL + kpos) * 128 + (hq & 1) * 64 + d1; *(u32x2*)k = p1; *(u32x2*)(k + 16) = p2; }
        }
        if (lane >= 16 && lane < 32) *(u32x4*)(Vb + ((size_t)b * KVL + kpos) * 128 + (lane - 16) * 8) = *(const u32x4*)(zr + ZV + (lane - 16) * 8);
    }
}

__device__ __forceinline__ bf16_t* gs_ptr(unsigned char* ws, size_t e) { return (bf16_t*)(ws + WS_Y) + (e >> 10) * 1536 + 512 + (e & 1023); }
__device__ __forceinline__ float logsig(float x) { return fminf(x, 0.f) - __logf(1.f + __expf(-fabsf(x))); }
#define GZI(t, j) ((t) * 32 + ((t) >> 4) * 8 + (j))
struct GlaGateW { float w[16]; float bias; };
__device__ __forceinline__ void gla_gate_weights(const AP& args, int li, int h, int tid, GlaGateW& W) {
    const int col = tid >> 2, dir = col >> 6, d = col & 63;
    const float* gw = args.in[11] + ((size_t)(li * 2 + dir) * 16) * 256 + h * 64 + d;
#pragma unroll
    for (int j = 0; j < 16; ++j) W.w[j] = gw[j * 256];
    W.bias = args.in[12][(li * 2 + dir) * 256 + h * 64 + d];
}
__device__ __forceinline__ void gla_gates(const GlaGateW& W, int tid, const LAS float* gz, LAS float* gcum) {
    const int q = tid & 3, col = tid >> 2, dir = col >> 6, dd = col & 63;
    float v[16];
#pragma unroll
    for (int i = 0; i < 16; ++i) { const int t = 16 * q + i; float x = W.bias;
#pragma unroll
        for (int j = 0; j < 16; ++j) x += gz[GZI(t, dir * 16 + j)] * W.w[j];
        v[i] = logsig(x) * (1.f / 16.f); }
    float tot;
    if (dir == 0) {
#pragma unroll
        for (int i = 1; i < 16; ++i) v[i] += v[i - 1];
        tot = v[15];
    } else {
#pragma unroll
        for (int i = 14; i >= 0; --i) v[i] += v[i + 1];
        tot = v[0];
    }
    const float u1 = __shfl_up(tot, 1), u2 = __shfl_up(tot, 2), u3 = __shfl_up(tot, 3), d1 = __shfl_down(tot, 1), d2 = __shfl_down(tot, 2), d3 = __shfl_down(tot, 3);
    const float off = (dir == 0) ? ((q >= 1 ? u1 : 0.f) + (q >= 2 ? u2 : 0.f) + (q >= 3 ? u3 : 0.f)) : ((q <= 2 ? d1 : 0.f) + (q <= 1 ? d2 : 0.f) + (q <= 0 ? d3 : 0.f));
    LAS float* gc = gcum + dir * 4096 + (16 * q) * 64 + dd;
#pragma unroll
    for (int i = 0; i < 16; ++i) gc[i * 64] = v[i] + off;
    __syncthreads();
}
__device__ __forceinline__ void gla_put_gz(const u32x2 w, int tid, LAS float* gz) {
    const int t = tid >> 3, j = (tid & 7) * 4;
    gz[GZI(t, j)] = bflo(w.x); gz[GZI(t, j + 1)] = bfhi(w.x); gz[GZI(t, j + 2)] = bflo(w.y); gz[GZI(t, j + 3)] = bfhi(w.y);
}
__device__ __forceinline__ void gla_put_vT(const u32x4 a, const u32x4 b, int tid, LAS bf16_t* dst, int ld) {
    const int t = tid >> 3, seg = tid & 7;
    const unsigned w[8] = {a.x, a.y, a.z, a.w, b.x, b.y, b.z, b.w};
#pragma unroll
    for (int i = 0; i < 8; ++i) { dst[(seg * 16 + 2 * i) * ld + t] = (bf16_t)(w[i] & 0xffffu); dst[(seg * 16 + 2 * i + 1) * ld + t] = (bf16_t)(w[i] >> 16); }
}
__device__ __forceinline__ void gla_state_phase(const AP& args, int li, LAS unsigned char* lds) {
    unsigned char* ws = args.ws; const bf16_t* Z = (const bf16_t*)(ws + WS_A); float* GD = (float*)(ws + WS_GD);
    const int tid = otid(), lane = tid & 63, wave = tid >> 6;
    LAS float* gz = (LAS float*)(lds + 77824); LAS float* gcum = (LAS float*)(lds + 8192);
    LAS bf16_t* koT = (LAS bf16_t*)(lds + 40960); LAS bf16_t* vT = (LAS bf16_t*)(lds + 59392);
    const int nslot = gridDim.x >> 3, h = blockIdx.x & 3, b = (blockIdx.x >> 2) & 1;
    if ((int)(blockIdx.x >> 3) >= nslot) return;
    GlaGateW GW; gla_gate_weights(args, li, h, tid, GW);
    for (int c = blockIdx.x >> 3; c < NCH; c += nslot) {
        const int r0 = chunk_row0(b, c);
        const u32x2 gzw = *(const u32x2*)(Z + (size_t)(r0 + (tid >> 3)) * ZP + GFB + (tid & 7) * 4);
        const bf16_t* vp_ = Z + (size_t)(r0 + (tid >> 3)) * ZP + GV + h * 128 + (tid & 7) * 16;
        const u32x4 va = *(const u32x4*)vp_, vb = *(const u32x4*)(vp_ + 8);
        const u32x4 kw = *(const u32x4*)(Z + (size_t)(r0 + (tid & 63)) * ZP + GK + h * 64 + (tid >> 6) * 8);
        gla_put_gz(gzw, tid, gz); gla_put_vT(va, vb, tid, vT, 72);
        __syncthreads();
        gla_gates(GW, tid, gz, gcum);
        { const int t = tid & 63, dg = tid >> 6;
          const float kv[8] = {bflo(kw.x), bfhi(kw.x), bflo(kw.y), bfhi(kw.y), bflo(kw.z), bfhi(kw.z), bflo(kw.w), bfhi(kw.w)};
#pragma unroll
          for (int dir = 0; dir < 2; ++dir)
#pragma unroll
              for (int i = 0; i < 8; ++i) { const int d = dg * 8 + i; const float tot = gcum[(dir * 64 + (dir ? 0 : 63)) * 64 + d];
                  koT[(dir * 64 + d) * 72 + t] = (bf16_t)f2bf(kv[i] * __expf(tot - gcum[(dir * 64 + t) * 64 + d])); }
          if (tid < 128) { const int dir = tid >> 6, d = tid & 63; GD[((size_t)((dir * 2 + b) * 4 + h) * NCH + c) * 64 + d] = __expf(gcum[(dir * 64 + (dir ? 0 : 63)) * 64 + d]); } }
        __syncthreads();
        for (int tt = wave; tt < 64; tt += 8) { const int dir = tt >> 5, it_ = (tt >> 3) & 3, jt = tt & 7;
            const f32x4 acc = mm_tile(koT + (dir * 64 + it_ * 16) * 72, 72, vT + (jt * 16) * 72, 72, 64, lane, (f32x4){0.f, 0.f, 0.f, 0.f});
            bf16_t* dst = gs_ptr(ws, ((size_t)((dir * 2 + b) * 4 + h) * NCH + c) * 8192 + (jt * 16 + (lane & 15)) * 64 + it_ * 16 + 4 * (lane >> 4));
            u32x2 o; o.x = pk2(acc[0], acc[1]); o.y = pk2(acc[2], acc[3]); *(u32x2*)dst = o; }
        __syncthreads();
    }
}
__device__ __forceinline__ void gla_out_phase(const AP& args, int li, LAS unsigned char* lds, int c0) {
    unsigned char* ws = args.ws; const bf16_t* Z = (const bf16_t*)(ws + WS_A); bf16_t* Y = (bf16_t*)(ws + WS_Y);
    const int tid = otid(), lane = tid & 63, wave = tid >> 6;
    LAS bf16_t* Acat = (LAS bf16_t*)lds;
    LAS bf16_t* Bcat = (LAS bf16_t*)(lds + 25600);
    LAS float* gz = (LAS float*)(lds + 136192);
    LAS float* gcum = (LAS float*)(lds + 84992);
    LAS bf16_t* kin = (LAS bf16_t*)(lds + 117760);
    LAS float* Of = (LAS float*)(lds + 84992);
    const int nslot = gridDim.x >> 3, h = blockIdx.x & 3, b = (blockIdx.x >> 2) & 1;
    if ((int)(blockIdx.x >> 3) >= nslot) return;
    GlaGateW GW; gla_gate_weights(args, li, h, tid, GW);
    for (int c = c0 + (blockIdx.x >> 3); c < NCH; c += nslot) {
        const int r0 = chunk_row0(b, c);
        const u32x2 gzw = *(const u32x2*)(Z + (size_t)(r0 + (tid >> 3)) * ZP + GFB + (tid & 7) * 4);
        const bf16_t* vp_ = Z + (size_t)(r0 + (tid >> 3)) * ZP + GV + h * 128 + (tid & 7) * 16;
        const u32x4 va = *(const u32x4*)vp_, vb = *(const u32x4*)(vp_ + 8);
        u32x4 gsv[4];
#pragma unroll
        for (int rep = 0; rep < 4; ++rep) { const int idx = tid + 512 * (rep & 1), dir = rep >> 1, dv = idx >> 3, seg = idx & 7;
            gsv[rep] = *(const u32x4*)gs_ptr(ws, ((size_t)((dir * 2 + b) * 4 + h) * NCH + c) * 8192 + dv * 64 + seg * 8); }
        const u32x4 qw = *(const u32x4*)(Z + (size_t)(r0 + (tid & 63)) * ZP + GQ + h * 64 + (tid >> 6) * 8), kw = *(const u32x4*)(Z + (size_t)(r0 + (tid & 63)) * ZP + GK + h * 64 + (tid >> 6) * 8);
        const bf16_t* rp_ = Z + (size_t)(r0 + (tid >> 3)) * ZP + GR + h * 128 + (tid & 7) * 16;
        const u32x4 ra = *(const u32x4*)rp_, rb = *(const u32x4*)(rp_ + 8);
        gla_put_gz(gzw, tid, gz); gla_put_vT(va, vb, tid, Bcat, 200);
#pragma unroll
        for (int rep = 0; rep < 4; ++rep) { const int idx = tid + 512 * (rep & 1), dir = rep >> 1, dv = idx >> 3, seg = idx & 7;
            *(LAS u32x4*)(Bcat + dv * 200 + 64 + dir * 64 + seg * 8) = gsv[rep]; }
        __syncthreads();
        gla_gates(GW, tid, gz, gcum);
        { const int t = tid & 63, dg = tid >> 6;
          const float qv[8] = {bflo(qw.x), bfhi(qw.x), bflo(qw.y), bfhi(qw.y), bflo(qw.z), bfhi(qw.z), bflo(qw.w), bfhi(qw.w)};
          const float kv[8] = {bflo(kw.x), bfhi(kw.x), bflo(kw.y), bfhi(kw.y), bflo(kw.z), bfhi(kw.z), bflo(kw.w), bfhi(kw.w)};
#pragma unroll
          for (int dir = 0; dir < 2; ++dir) { float qo[8], ko[8];
#pragma unroll
              for (int i = 0; i < 8; ++i) { const float bb = gcum[(dir * 64 + t) * 64 + dg * 8 + i]; qo[i] = qv[i] * __expf(bb) * 0.125f; ko[i] = kv[i] * __expf(-bb); }
              u32x4 o; o.x = pk2(qo[0], qo[1]); o.y = pk2(qo[2], qo[3]); o.z = pk2(qo[4], qo[5]); o.w = pk2(qo[6], qo[7]);
              *(LAS u32x4*)(Acat + t * 200 + 64 + dir * 64 + dg * 8) = o;
              o.x = pk2(ko[0], ko[1]); o.y = pk2(ko[2], ko[3]); o.z = pk2(ko[4], ko[5]); o.w = pk2(ko[6], ko[7]);
              *(LAS u32x4*)(kin + (dir * 64 + t) * 72 + dg * 8) = o; } }
        __syncthreads();
        for (int tt = wave; tt < 16; tt += 8) { const int it_ = tt >> 2, jt = tt & 3;
            const f32x4 af = mm_tile(kin + (it_ * 16) * 72, 72, Acat + (jt * 16) * 200 + 64, 200, 64, lane, (f32x4){0.f, 0.f, 0.f, 0.f});
            const f32x4 ab = mm_tile(kin + (64 + it_ * 16) * 72, 72, Acat + (jt * 16) * 200 + 128, 200, 64, lane, (f32x4){0.f, 0.f, 0.f, 0.f});
            const int i = jt * 16 + (lane & 15), j0 = it_ * 16 + 4 * (lane >> 4); float v[4];
#pragma unroll
            for (int q = 0; q < 4; ++q) { const int j = j0 + q; v[q] = (j <= i ? af[q] : 0.f) + (j >= i ? ab[q] : 0.f); }
            u32x2 o; o.x = pk2(v[0], v[1]); o.y = pk2(v[2], v[3]); *(LAS u32x2*)(Acat + i * 200 + j0) = o; }
        __syncthreads();
        for (int tt = wave; tt < 32; tt += 8) { const int it_ = tt >> 2, jt = tt & 3;
            const f32x4 acc = mm_tile(Bcat + (it_ * 16) * 200, 200, Acat + (jt * 16) * 200, 200, 192, lane, (f32x4){0.f, 0.f, 0.f, 0.f});
            *(LAS f32x4*)(Of + (jt * 16 + (lane & 15)) * 132 + it_ * 16 + 4 * (lane >> 4)) = acc; }
        __syncthreads();
        { const int t = tid >> 3, seg = tid & 7; float o[16]; float ss = 0.f;
#pragma unroll
          for (int q = 0; q < 4; ++q) { const f32x4 v = *(const LAS f32x4*)(Of + t * 132 + seg * 16 + 4 * q); o[4 * q] = v.x; o[4 * q + 1] = v.y; o[4 * q + 2] = v.z; o[4 * q + 3] = v.w; ss += (v.x * v.x + v.y * v.y) + (v.z * v.z + v.w * v.w); }
          ss += __shfl_xor(ss, 1); ss += __shfl_xor(ss, 2); ss += __shfl_xor(ss, 4);
          const float rs = 1.0f / sqrtf(ss * (1.f / 128.f) + EPS);
          const unsigned rw[8] = {ra.x, ra.y, ra.z, ra.w, rb.x, rb.y, rb.z, rb.w};
          const float* nw = args.in[13] + li * 128 + seg * 16;
          unsigned ow[8];
#pragma unroll
          for (int q = 0; q < 8; ++q) { const float y0 = o[2 * q] * rs * nw[2 * q] * siluf_(bflo(rw[q])), y1 = o[2 * q + 1] * rs * nw[2 * q + 1] * siluf_(bfhi(rw[q])); ow[q] = pk2(y0, y1); }
          bf16_t* yp = Y + (size_t)(r0 + t) * 1536 + h * 128 + seg * 16;
          *(u32x4*)yp = (u32x4){ow[0], ow[1], ow[2], ow[3]}; *(u32x4*)(yp + 8) = (u32x4){ow[4], ow[5], ow[6], ow[7]}; }
    }
    __syncthreads();
}

template <bool OUT> __device__ __forceinline__ void s5_phase(const AP& args, int li, LAS unsigned char* lds, int j0s) {
    unsigned char* ws = args.ws; const bf16_t* Z = (const bf16_t*)(ws + WS_A);
    const float* Atab = (const float*)(ws + WS_S5A) + (size_t)li * 16384; const bf16_t* Btab = (const bf16_t*)(ws + WS_S5B) + (size_t)li * 131072; const bf16_t* Ctab = (const bf16_t*)(ws + WS_S5C) + (size_t)li * 65536;
    f32x2* E = (f32x2*)(ws + WS_S5E); bf16_t* Y5 = (bf16_t*)(ws + WS_Y5);
    const int tid = otid(), lane = tid & 63, wave = tid >> 6;
    constexpr int LDB = 136, BUF = 64 * LDB;
    LAS bf16_t* buf = (LAS bf16_t*)lds;
    const int nslot = gridDim.x >> 3, gq = blockIdx.x & 7;
    if ((int)(blockIdx.x >> 3) >= nslot) return;
    const int ks = (lane >> 4) & 1; const bool kz = (lane >> 4) >= 2;
    const bf16x8 zero8 = (bf16x8){0, 0, 0, 0, 0, 0, 0, 0};
    const int gB = gq * 4 + (wave >> 1), dirB = wave & 1;
    bf16x8 xb[8];
#pragma unroll
    for (int it_ = 0; it_ < 8; ++it_) { xb[it_] = *(const bf16x8*)(Btab + ((size_t)(dirB * 32 + gB) * 128 + it_ * 16 + (lane & 15)) * 16 + 8 * ks); if (kz) xb[it_] = zero8; }
    const int p = tid & 63, dir_s = (tid >> 6) & 1, g_s = gq * 4 + (tid >> 7);
    const f32x4 A = *(const f32x4*)(Atab + (size_t)((dir_s * 32 + g_s) * 64 + p) * 4);
    bf16x8 xc[2][4]; f32x4 dd[2];
    if (OUT) {
#pragma unroll
        for (int k = 0; k < 2; ++k) { const int g = gq * 4 + (wave >> 2) + 2 * k;
#pragma unroll
            for (int kk = 0; kk < 4; ++kk) xc[k][kk] = *(const bf16x8*)(Ctab + (size_t)(g * 16 + (lane & 15)) * 128 + 8 * (lane >> 4) + 32 * kk);
            dd[k] = *(const f32x4*)(args.in[21] + li * 512 + g * 16 + 4 * (lane >> 4)); }
    }
#define S5_LOAD(J, YB, H0R, H0I, UW) do { const int b_ = (J) & 1, c_ = (J) >> 1, r0_ = chunk_row0(b_, c_); \
        _Pragma("unroll") for (int jt = 0; jt < 4; ++jt) { YB[jt] = *(const bf16x8*)(Z + (size_t)(r0_ + jt * 16 + (lane & 15)) * ZP + SU + gB * 16 + 8 * ks); if (kz) YB[jt] = zero8; } \
        if (OUT) { const f32x2 h0_ = E[((size_t)((dir_s * 2 + b_) * 32 + g_s) * NCH + c_) * 64 + p]; H0R = h0_.x; H0I = h0_.y; \
            _Pragma("unroll") for (int k = 0; k < 2; ++k) UW[k] = *(const u32x2*)(Z + (size_t)(r0_ + (wave & 3) * 16 + (lane & 15)) * ZP + SU + (gq * 4 + (wave >> 2) + 2 * k) * 16 + 4 * (lane >> 4)); } } while (0)
    bf16x8 yb[4], ybn[4]; float h0r = 0.f, h0i = 0.f, hnr = 0.f, hni = 0.f; u32x2 uw[2], uwn[2];
    uw[0] = uw[1] = uwn[0] = uwn[1] = (u32x2){0u, 0u};
#pragma unroll
    for (int jt = 0; jt < 4; ++jt) ybn[jt] = zero8;
    { const int j0 = j0s + (blockIdx.x >> 3); if (j0 < NCH * 2) S5_LOAD(j0, yb, h0r, h0i, uw); }
    for (int j = j0s + (blockIdx.x >> 3); j < NCH * 2; j += nslot) {
        const int b = j & 1, c = j >> 1, r0 = chunk_row0(b, c);
        const size_t eidx = ((size_t)((dir_s * 2 + b) * 32 + g_s) * NCH + c) * 64 + p;
#pragma unroll
        for (int jt = 0; jt < 4; ++jt)
#pragma unroll
            for (int it_ = 0; it_ < 8; ++it_) {
                const f32x4 acc = __builtin_amdgcn_mfma_f32_16x16x32_bf16(xb[it_], yb[jt], (f32x4){0.f, 0.f, 0.f, 0.f}, 0, 0, 0);
                u32x2 o; o.x = pk2(acc[0], acc[1]); o.y = pk2(acc[2], acc[3]);
                *(LAS u32x2*)(buf + wave * BUF + (jt * 16 + (lane & 15)) * LDB + it_ * 16 + 4 * (lane >> 4)) = o; }
        if (j + nslot < NCH * 2) S5_LOAD(j + nslot, ybn, hnr, hni, uwn);
        asm volatile("s_waitcnt lgkmcnt(0)" ::: "memory");
        float hr = h0r, hi = h0i;
        { LAS unsigned* bp = (LAS unsigned*)(buf + wave * BUF + 2 * p);
          for (int s0 = 0; s0 < 64; s0 += 8) { unsigned w[8], o[8];
#pragma unroll
              for (int q = 0; q < 8; ++q) { const int t = dir_s ? 63 - (s0 + q) : s0 + q; w[q] = bp[t * (LDB / 2)]; }
#pragma unroll
              for (int q = 0; q < 8; ++q) { const float nr = A.x * hr - A.y * hi + bflo(w[q]), ni = A.x * hi + A.y * hr + bfhi(w[q]); hr = nr; hi = ni; o[q] = pk2(hr, hi); }
              if (OUT) {
#pragma unroll
                  for (int q = 0; q < 8; ++q) { const int t = dir_s ? 63 - (s0 + q) : s0 + q; bp[t * (LDB / 2)] = o[q]; } } }
          if (!OUT) E[eidx] = (f32x2){hr, hi}; }
        if (OUT) __syncthreads(); else asm volatile("s_waitcnt lgkmcnt(0)" ::: "memory");
        if (OUT) {
#pragma unroll
            for (int k = 0; k < 2; ++k) { const int gi = (wave >> 2) + 2 * k, jt = wave & 3, g = gq * 4 + gi;
                f32x4 acc = (f32x4){0.f, 0.f, 0.f, 0.f};
#pragma unroll
                for (int dir = 0; dir < 2; ++dir) { const LAS bf16_t* yp = buf + (gi * 2 + dir) * BUF + (jt * 16 + (lane & 15)) * LDB + 8 * (lane >> 4);
#pragma unroll
                    for (int kk = 0; kk < 4; ++kk) acc = __builtin_amdgcn_mfma_f32_16x16x32_bf16(xc[k][kk], *(const LAS bf16x8*)(yp + 32 * kk), acc, 0, 0, 0); }
                const int t = jt * 16 + (lane & 15), c4 = 4 * (lane >> 4);
                const float y0 = gelu_tanh(acc[0] + dd[k].x * bflo(uw[k].x)), y1 = gelu_tanh(acc[1] + dd[k].y * bfhi(uw[k].x)), y2 = gelu_tanh(acc[2] + dd[k].z * bflo(uw[k].y)), y3 = gelu_tanh(acc[3] + dd[k].w * bfhi(uw[k].y));
                u32x2 o; o.x = pk2(y0, y1); o.y = pk2(y2, y3);
                *(u32x2*)(Y5 + (size_t)(r0 + t) * 512 + g * 16 + c4) = o; }
            __syncthreads();
        }
#pragma unroll
        for (int jt = 0; jt < 4; ++jt) yb[jt] = ybn[jt];
        h0r = hnr; h0i = hni; uw[0] = uwn[0]; uw[1] = uwn[1];
    }
#undef S5_LOAD
}

__device__ __forceinline__ void scan_phase(const AP& args, int li) {
    unsigned char* ws = args.ws; const float* GD = (const float*)(ws + WS_GD);
    f32x2* E = (f32x2*)(ws + WS_S5E); const float* Atab = (const float*)(ws + WS_S5A) + (size_t)li * 16384;
    const int gt = blockIdx.x * 512 + otid(), NTH = gridDim.x * 512;
    constexpr int NB = 10;
    for (int e = gt; e < 16 * 8192; e += NTH) {
        const int combo = e >> 13, el = e & 8191, dk = el & 63, dir = combo >> 3;
        const size_t ebase0 = (size_t)combo * NCH * 8192 + el; const float* dbase = GD + (size_t)combo * NCH * 64 + dk;
        const bool s5 = e < 8192;
        const int p = e & 63, g = (e >> 6) & 31, b5 = (e >> 11) & 1, dir5 = (e >> 12) & 1;
        const f32x4 A = s5 ? *(const f32x4*)(Atab + (size_t)((dir5 * 32 + g) * 64 + p) * 4) : (f32x4){0.f, 0.f, 0.f, 0.f};
        f32x2* ebase = E + ((size_t)((dir5 * 2 + b5) * 32 + g) * NCH) * 64 + p;
        float S = 0.f, hr = 0.f, hi = 0.f;
        float d0[NB], c0[NB], d1[NB], c1[NB]; f32x2 v0[NB], v1[NB];
#define SC_LOAD(D, C, V, S0) do { _Pragma("unroll") for (int q = 0; q < NB; ++q) { const int cc_ = chunk_of((S0) + q, dir); D[q] = bf2f(*gs_ptr(ws, ebase0 + (size_t)cc_ * 8192)); C[q] = dbase[cc_ * 64]; } \
        if (s5) { _Pragma("unroll") for (int q = 0; q < NB; ++q) V[q] = ebase[chunk_of((S0) + q, dir5) * 64]; } } while (0)
#define SC_RUN(D, C, V, S0) do { _Pragma("unroll") for (int q = 0; q < NB; ++q) { const int cc_ = chunk_of((S0) + q, dir); *gs_ptr(ws, ebase0 + (size_t)cc_ * 8192) = (bf16_t)f2bf(S); S = C[q] * S + D[q]; } \
        if (s5) { _Pragma("unroll") for (int q = 0; q < NB; ++q) { ebase[chunk_of((S0) + q, dir5) * 64] = (f32x2){hr, hi}; const float nr = A.z * hr - A.w * hi + V[q].x, ni = A.z * hi + A.w * hr + V[q].y; hr = nr; hi = ni; } } } while (0)
        SC_LOAD(d0, c0, v0, 0);
        for (int s = 0; s < NCH; s += 2 * NB) {
            SC_LOAD(d1, c1, v1, s + NB);
            SC_RUN(d0, c0, v0, s);
            if (s + 2 * NB < NCH) SC_LOAD(d0, c0, v0, s + 2 * NB);
            SC_RUN(d1, c1, v1, s + NB);
        }
#undef SC_LOAD
#undef SC_RUN
    }
}

__device__ __forceinline__ void final_phase(const AP& args) {
    const int tid_ = otid(), lane = tid_ & 63, gw = blockIdx.x * 8 + (tid_ >> 6), NGW = gridDim.x * 8;
    const float* nw = args.in[30];
    for (int r = gw; r < MLAT; r += NGW) {
        float* xr = args.out + (size_t)r * DM;
        f32x4 v[4]; float s = 0.f;
#pragma unroll
        for (int j = 0; j < 4; ++j) { v[j] = *(const f32x4*)(xr + 4 * (lane + 64 * j)); s += (v[j].x * v[j].x + v[j].y * v[j].y) + (v[j].z * v[j].z + v[j].w * v[j].w); }
        const float rs = 1.0f / sqrtf(wave_sum(s) * (1.f / DM) + EPS);
#pragma unroll
        for (int j = 0; j < 4; ++j) { const int c = 4 * (lane + 64 * j); *(f32x4*)(xr + c) = v[j] * rs * *(const f32x4*)(nw + c); }
    }
}

constexpr size_t WS_BAR = 3584 * 1024;
#define XB_TMO      128
#define XB_XCNT(j)  (256  + 64 * (j))
#define XB_XSUB(j)  (1280 + 64 * (j))
#define XB_XGEN(j)  (2304 + 64 * (j))
#define XB_TOP      3328
#define XB_TOPGEN   3392
#define XCD_BAR_WORDS 3456
#define XB_SPIN_CAP (1u << 18)
__device__ __forceinline__ unsigned xb_ld(unsigned* p)              { return __hip_atomic_load(p, __ATOMIC_RELAXED, __HIP_MEMORY_SCOPE_AGENT); }
__device__ __forceinline__ unsigned xb_add(unsigned* p, unsigned v) { return __hip_atomic_fetch_add(p, v, __ATOMIC_RELAXED, __HIP_MEMORY_SCOPE_AGENT); }
__device__ __forceinline__ unsigned xb_xcc_id() { return (unsigned)__builtin_amdgcn_s_getreg((3 << 11) | 20) & 0xFu; }
#define XB_SPIN(cond, bar) do { unsigned _sp = 0; while (cond) { __builtin_amdgcn_s_sleep(1); \
    if ((++_sp & 255u) == 0u) { if (xb_ld(&(bar)[XB_TMO])) break; if (_sp > XB_SPIN_CAP) { atomicAdd(&(bar)[XB_TMO], 1u); break; } } } } while (0)
__shared__ unsigned xb_st[4];
struct XcdBarrier { unsigned* bar; unsigned x; };
__device__ __forceinline__ XcdBarrier xcd_barrier_post(unsigned* bar) {
    XcdBarrier b; b.bar = bar; b.x = xb_xcc_id();
    if (threadIdx.x == 0) (void)xb_add(&bar[XB_XCNT(b.x)], 1u);
    return b;
}
__device__ __forceinline__ void xcd_barrier_complete(unsigned* bar, unsigned x, unsigned& nloc, unsigned& nx) {
    const unsigned G = gridDim.x * gridDim.y * gridDim.z;
    unsigned sum, cnt, mine, sp = 0u;
    for (;;) {
        sum = 0u; cnt = 0u; mine = 0u;
#pragma unroll
        for (unsigned j = 0; j < 16; ++j) { const unsigned c = xb_ld(&bar[XB_XCNT(j)]); sum += c; cnt += (c > 0u) ? 1u : 0u; mine = (j == x) ? c : mine; }
        if (sum == G) break;
        __builtin_amdgcn_s_sleep(1);
        if ((++sp & 255u) == 0u) { if (xb_ld(&bar[XB_TMO])) break; if (sp > XB_SPIN_CAP) { atomicAdd(&bar[XB_TMO], 1u); break; } }
    }
    nloc = mine > 0u ? mine : 1u; nx = cnt > 0u ? cnt : 1u;
}
__device__ __forceinline__ void xcd_barrier(const XcdBarrier& b) {
    asm volatile("s_waitcnt vmcnt(0)" ::: "memory");
    __syncthreads();
    if (threadIdx.x == 0) {
        unsigned* bar = b.bar;
        __builtin_amdgcn_s_waitcnt(0);
        volatile unsigned* st = xb_st;
        unsigned nloc = st[0], nx = st[1];
        if (nloc == 0u) { xcd_barrier_complete(bar, b.x, nloc, nx); st[0] = nloc; st[1] = nx; }
        const unsigned old = xb_add(&bar[XB_XSUB(b.x)], 1u);
        const unsigned gen = old / nloc;
        if (old + 1u == (gen + 1u) * nloc) {
            __builtin_amdgcn_fence(__ATOMIC_RELEASE, "agent");
            asm volatile("s_waitcnt vmcnt(0)" ::: "memory");
            const unsigned og = xb_add(&bar[XB_TOP], 1u);
            const unsigned tg = og / nx;
            if (og + 1u == (tg + 1u) * nx) xb_add(&bar[XB_TOPGEN], 1u);
            else XB_SPIN(xb_ld(&bar[XB_TOPGEN]) == tg, bar);
            __builtin_amdgcn_fence(__ATOMIC_ACQUIRE, "agent");
            xb_add(&bar[XB_XGEN(b.x)], 1u);
            asm volatile("s_waitcnt vmcnt(0)" ::: "memory");
        } else {
            XB_SPIN(xb_ld(&bar[XB_XGEN(b.x)]) == gen, bar);
            __builtin_amdgcn_fence(__ATOMIC_ACQUIRE, "agent");
            asm volatile("s_waitcnt vmcnt(0)" ::: "memory");
        }
    }
    __syncthreads();
}
#ifndef MAXPC
#define MAXPC 32
#endif
#ifndef PROBE_MASK
#define PROBE_MASK 0
#endif
#define PROBEB(bit, ...) do { if (PROBE_MASK & (bit)) { __VA_ARGS__ } } while (0)
template <int LI> __device__ __forceinline__ void run_layer(const AP& args0, LAS unsigned char* lds, unsigned char* lds_raw, const XcdBarrier& xbar, int lim) {
    constexpr int li = LI;
    const int G = gridDim.x;
#pragma unroll 1
    for (int s = 0; s < 16 && (LI * 16 + s) < lim; ++s) {
        AP args = args0; { unsigned char* w_ = args0.ws; float* o_ = args0.out; asm volatile("" : "+s"(w_), "+s"(o_)); args.ws = w_; args.out = o_; }
        unsigned char* ws = args.ws;
        float* hctx = (float*)(ws + WS_HCTX);
        bf16_t* XN = (bf16_t*)(ws + WS_XN);
        bf16_t* AB = (bf16_t*)(ws + WS_A);
        bf16_t* Y = (bf16_t*)(ws + WS_Y);
        const float* mods = (const float*)(ws + WS_MODS) + (size_t)li * 3 * NMOD;
        const float* hl = args.out; const float* hc = hctx;
        if (s == 1) continue;
        if (s == 0 && LI > 0) { prep_phase(args, li, lds); __syncthreads(); }
        if (s == 0 || s == 4 || s == 13) {
            const int a = (s == 0) ? 0 : (s == 13 ? 2 : 1);
            const int npart = (s == 13) ? (LI == 0 ? 4 : 0) : ((s == 4 || (s == 0 && LI > 0)) ? 11 : 0);
            const bool inp = (LI == 0 && s == 0);
            norm_phase(inp ? args.in[0] : hl, inp ? args.in[2] : (const float*)hctx, inp ? args.out : (float*)nullptr, hctx, args.in[6] + (li * 3 + a) * DM, mods, a * 3, XN, (const float*)(ws + WS_Y), npart);
        }
        if (s == 6) { attn_prep(args, li); gla_state_phase(args, li, lds); s5_phase<false>(args, li, lds, 0); PROBEB(4, attn_prep(args, li);); PROBEB(8, gla_state_phase(args, li, lds);); PROBEB(16, s5_phase<false>(args, li, lds, 0);); }
        if (s == 7) scan_phase(args, li);
        if (s == 8) {
            gla_out_phase(args, li, lds, LI == 1 ? 4 : 0);
            s5_phase<true>(args, li, lds, LI == 1 ? 8 : 0);
            xcd_barrier(xbar);
            const attn_body::bf16* Qb = (const attn_body::bf16*)(ws + WS_QB); const attn_body::bf16* Kb = (const attn_body::bf16*)(ws + WS_KB); const attn_body::bf16* Vb = (const attn_body::bf16*)(ws + WS_VB);
            attn_body::bf16* Yo = (attn_body::bf16*)(ws + WS_Y);
            for (int u = blockIdx.x; u < 1024; u += G) { const int b = u >> 9, qb = (u >> 3) & 63, h = u & 7; const size_t qrow = (size_t)b * SEQL + qb * 256;
                attn_body::attn_unit<8>(Qb + qrow * 512 + h * 64, Kb + (size_t)b * KVL * 128 + (h >> 2) * 64, Vb + (size_t)b * KVL * 128 + (h >> 2) * 64, Yo + qrow * 1536 + 1024 + h * 64, KVL / 64, (char*)lds_raw); }
            if (LI == 0) for (int u = blockIdx.x; u < 16; u += G) { const int b = u >> 3, h = u & 7; const size_t qrow = (size_t)MLAT + b * CTXL;
                attn_body::attn_unit<8>(Qb + qrow * 512 + h * 64, Kb + (size_t)b * KVL * 128 + (h >> 2) * 64, Vb + (size_t)b * KVL * 128 + (h >> 2) * 64, Yo + qrow * 1536 + 1024 + h * 64, CTXL / 64, (char*)lds_raw); }
        }
        const bool is_gemm = (s == 2 || s == 3 || s == 5 || (s >= 9 && s <= 12) || s == 14 || s == 15);
        if (is_gemm) {
            __syncthreads();
            const bf16_t* Wb = (const bf16_t*)(ws + WS_W);
            pg8::StaticOrder S;
            constexpr int MPOST = (LI == 1) ? MLAT : MT;
            if (s == 2 || s == 14) { const int f = (s == 14);
                S.init(f ? MPOST : MT, 5632, G, (int)blockIdx.x, 16);
                for (int rep_ = 0; rep_ < ((PROBE_MASK & 256) ? 2 : 1); ++rep_) { if (rep_) __syncthreads();
                pg8::gemm_phase<pg8::EpiSwiglu, pg8::StaticOrder, 1024, 1024, 1024, 30, 0>(lds, pg8::Gemm{XN, Wb + (W_GU / 2) + (size_t)f * 5632 * 1024}, S, pg8::EpiSwiglu{AB}); } }
            else if (s == 3 || s == 15) { const int f = (s == 15);
                pg8::SplitOrder SS; SS.init(G, (int)blockIdx.x, FFH / 64, !(LI == 1 && f));
                if (PROBE_MASK & 1024) { pg8::gemm_phase<pg8::EpiResid, pg8::SplitOrder, FFH, FFH, FFH, 30, 0>(lds, pg8::Gemm{AB, Wb + (W_DN / 2) + (size_t)f * 1024 * FFH}, SS, pg8::EpiResid{args.out, (float*)(ws + WS_Y), mods + (f ? 8 : 2) * DM, 0.0f}); __syncthreads(); }
                pg8::gemm_phase<pg8::EpiResid, pg8::SplitOrder, FFH, FFH, FFH, 30, 0>(lds, pg8::Gemm{AB, Wb + (W_DN / 2) + (size_t)f * 1024 * FFH}, SS, pg8::EpiResid{args.out, (float*)(ws + WS_Y), mods + (f ? 8 : 2) * DM, 0.5f}); }
            else if (s == 5) { S.init(MT, 3072, G, (int)blockIdx.x, 16);
                pg8::gemm_phase<pg8::EpiBf<0, ZP, ZP>, pg8::StaticOrder, 1024, 1024, 1024, 30, 0>(lds, pg8::Gemm{XN, Wb + (W_IN / 2)}, S, pg8::EpiBf<0, ZP, ZP>{AB, nullptr, nullptr}); }
            else if (s == 9) { S.init(MPOST, 512, G, (int)blockIdx.x, 8);
                pg8::gemm_phase<pg8::EpiBf<3, 1536, 512>, pg8::StaticOrder, 512, 512, 512, 30, 0>(lds, pg8::Gemm{(const bf16_t*)(ws + WS_Y5), Wb + (W_GL / 2)}, S, pg8::EpiBf<3, 1536, 512>{Y + 512, (const bf16_t*)(ws + WS_Y5), args.in[23] + li * 512}); }
            else if (s == 10) { S.init(MPOST, 3072, G, (int)blockIdx.x, 16);
                pg8::gemm_phase<pg8::EpiBf<5, 3072, 3072>, pg8::StaticOrder, 1024, 1024, 1024, 30, 0>(lds, pg8::Gemm{XN, Wb + (W_BG / 2)}, S, pg8::EpiBf<5, 3072, 3072>{AB, nullptr, args.in[27] + li * 3072}); }
            else if (s == 11) { pg8::BranchOrder BO; BO.init(MPOST, G, (int)blockIdx.x, 8);
                pg8::gemm_phase<pg8::EpiBranch, pg8::BranchOrder, 512, 1536, 512, 2, 512>(lds, pg8::Gemm{Y, Wb + (W_PJ / 2)}, BO, pg8::EpiBranch{AB, XN}); }
            else { pg8::SplitOrder SS; SS.init(G, (int)blockIdx.x, 1024 / 64, LI == 0);
                pg8::gemm_phase<pg8::EpiResid, pg8::SplitOrder, 1024, 1024, 1024, 30, 0>(lds, pg8::Gemm{XN, Wb + (W_O3 / 2)}, SS, pg8::EpiResid{args.out, (float*)(ws + WS_Y), mods + 5 * DM, 1.f}); }
        }
        xcd_barrier(xbar);
    }
}
__global__ void __launch_bounds__(512, 2) fwd_megakernel(Args kargs) {
    extern __shared__ __attribute__((aligned(16))) unsigned char lds_raw[];
    LAS unsigned char* lds = (LAS unsigned char*)lds_raw;
    cg::grid_group grid = cg::this_grid();
    const AP& args = kargs;
    if (threadIdx.x < 4) xb_st[threadIdx.x] = 0u;
    if (blockIdx.x == 0) {
        unsigned* bw = (unsigned*)(kargs.ws + WS_BAR);
        for (int i = threadIdx.x; i < XCD_BAR_WORDS; i += 512) __hip_atomic_store(bw + i, 0u, __ATOMIC_RELAXED, __HIP_MEMORY_SCOPE_AGENT);
    }
    __syncthreads();
    tables_phase(args, lds);
    __syncthreads();
    prep_phase(args, 0, lds);
    grid.sync();
    const XcdBarrier xbar = xcd_barrier_post((unsigned*)(kargs.ws + WS_BAR));
    int lim = MAXPC; asm volatile("" : "+s"(lim));
    run_layer<0>(args, lds, lds_raw, xbar, lim);
    run_layer<1>(args, lds, lds_raw, xbar, lim);
    final_phase(args);
}

extern "C" void kernel_launch(void* const* d_in, const int* in_sizes, int n_in, void* d_out, int out_size, void* d_ws, size_t ws_size, hipStream_t stream) {
    static int grid = 0;
    if (grid == 0) {
        int dev = 0, cus = 0, per_cu = 0;
        (void)hipGetDevice(&dev);
        (void)hipDeviceGetAttribute(&cus, hipDeviceAttributeMultiprocessorCount, dev);
        if (hipFuncSetAttribute((const void*)fwd_megakernel, hipFuncAttributeMaxDynamicSharedMemorySize, LDS_BYTES) != hipSuccess) fprintf(stderr, "kernel_launch: hipFuncSetAttribute failed\n");
        if (hipOccupancyMaxActiveBlocksPerMultiprocessor(&per_cu, (const void*)fwd_megakernel, 512, LDS_BYTES) != hipSuccess || per_cu < 1) { fprintf(stderr, "kernel_launch: occupancy query says %d\n", per_cu); per_cu = 1; }
        (void)hipGetLastError();
        if (cus <= 0) cus = 256;
        grid = cus * 1;
        if (ws_size < WS_END || n_in != 31) fprintf(stderr, "kernel_launch: ws %zu (need %zu), n_in %d\n", ws_size, (size_t)WS_END, n_in);
    }
    if (ws_size < WS_END) return;
    { static const int exp_sz[31] = {33554432, 2048, 524288, 1024, 18874368, 18432, 6144, 11534336, 11534336, 11534336, 5832704, 16384, 1024, 256, 8192, 8192, 128, 65536, 65536, 65536, 65536, 1024, 524288, 1024, 128, 128, 6291456, 6144, 3145728, 2097152, 1024};
      if (n_in != 31 || out_size != 33554432) return;
      for (int i = 0; i < 31; ++i) if (in_sizes[i] != exp_sz[i]) { fprintf(stderr, "kernel_launch: input %d has %d elements, expected %d\n", i, in_sizes[i], exp_sz[i]); return; } }
    Args a{};
    for (int i = 0; i < 31; ++i) a.in[i] = (const float*)d_in[i];
    a.out = (float*)d_out; a.ws = (unsigned char*)d_ws;
    void* kargs[] = {&a};
    hipError_t e = hipLaunchCooperativeKernel((const void*)fwd_megakernel, dim3(grid), dim3(512), kargs, LDS_BYTES, stream);
    if (e != hipSuccess) fprintf(stderr, "cooperative launch failed: %s (grid %d)\n", hipGetErrorString(e), grid);
}
```
